# Optimizing an MI355X kernel written in HIP

```python
import math
import jax
import jax.numpy as jnp
from jax import lax
import numpy as np

D_MODEL = 1024
BATCH = 2
SEQ = 16384
DEPTH = 2

MEM_LEN = 256
EPS = 1e-6
MASK_VALUE = -1e30
TINY = 1e-30

A_HEADS = 8
A_NOPE = 64
A_ROPE = 32
A_V = 64
A_Q_RANK = 384
A_KV_RANK = 256
A_QBLOCK = 128
ROPE_THETA = 10000.0

B_HEADS = 8
B_DK = 128
B_DV = 64
B_CHUNK = 16

C_HEADS = 8
C_KV_HEADS = 2
C_DH = 64
C_WINDOW = 128
C_BLOCK = 128

REL_BUCKETS = 32
REL_MAX_DIST = 128

X_HEADS = 4
X_DH = 256

D_FF = -(-(8 * D_MODEL) // (3 * 256)) * 256

IN_SPLITS = (
    A_Q_RANK, A_KV_RANK, A_ROPE,
    B_HEADS * B_DK, B_HEADS * B_DK, B_HEADS * B_DK,
    B_HEADS * B_DV, B_HEADS * B_DV,
    C_HEADS * C_DH, C_KV_HEADS * C_DH, C_KV_HEADS * C_DH,
    D_MODEL, D_MODEL, D_MODEL,
)
IN_WIDTH = sum(IN_SPLITS)

kernel_name = 'hybrid_mla_hgrn2_swa_encoder'


def _rmsnorm(x, g):
    x32 = x.astype(jnp.float32)
    y = x32 * lax.rsqrt(jnp.mean(x32 * x32, axis=-1, keepdims=True) + EPS)
    return (y * g.astype(jnp.float32)).astype(x.dtype)


def _split_cols(z, sizes):
    out, start = [], 0
    for s in sizes:
        out.append(z[..., start:start + s])
        start += s
    return out


def _rope(x, pos):
    half = x.shape[-1] // 2
    inv = ROPE_THETA ** (-jnp.arange(half, dtype=jnp.float32) / half)
    ang = pos.astype(jnp.float32)[:, None] * inv[None, :]
    cos = jnp.cos(ang)[None, :, None, :]
    sin = jnp.sin(ang)[None, :, None, :]
    x32 = x.astype(jnp.float32)
    x1, x2 = x32[..., :half], x32[..., half:]
    return jnp.concatenate([x1 * cos - x2 * sin, x1 * sin + x2 * cos], axis=-1).astype(x.dtype)


def _t5_bucket(rel):
    nb = REL_BUCKETS // 2
    max_exact = nb // 2
    ret = (rel > 0).astype(jnp.int32) * nb
    n = jnp.abs(rel)
    large = max_exact + (jnp.log(jnp.maximum(n, 1).astype(jnp.float32) / max_exact)
                         / math.log(REL_MAX_DIST / max_exact) * (nb - max_exact)).astype(jnp.int32)
    large = jnp.minimum(large, nb - 1)
    return ret + jnp.where(n < max_exact, n, large)


def _mla(cq, ckv, kr, gq, gkv, wuq, wukv, pos):
    Bsz, S, _ = cq.shape
    q = (_rmsnorm(cq, gq) @ wuq).reshape(Bsz, S, A_HEADS, A_NOPE + A_ROPE)
    q = jnp.concatenate([q[..., :A_NOPE], _rope(q[..., A_NOPE:], pos)], axis=-1)
    kv = (_rmsnorm(ckv, gkv) @ wukv).reshape(Bsz, S, A_HEADS, A_NOPE + A_V)
    k_rope = jnp.broadcast_to(_rope(kr[:, :, None, :], pos), (Bsz, S, A_HEADS, A_ROPE))
    k = jnp.concatenate([kv[..., :A_NOPE], k_rope], axis=-1)
    v = kv[..., A_NOPE:]
    scale = (A_NOPE + A_ROPE) ** -0.5
    nb = S // A_QBLOCK
    qb = jnp.moveaxis(q.reshape(Bsz, nb, A_QBLOCK, A_HEADS, A_NOPE + A_ROPE), 1, 0)

    def attend(q_blk):
        s = jnp.einsum('bqhd,bkhd->bhqk', q_blk, k).astype(jnp.float32) * scale
        p = jax.nn.softmax(s, axis=-1).astype(v.dtype)
        return jnp.einsum('bhqk,bkhd->bqhd', p, v)

    o = lax.map(attend, qb)
    return jnp.moveaxis(o, 0, 1).reshape(Bsz, S, A_HEADS * A_V)


def _gated_scan(q, k, v, log_f):
    Bsz, S, H, DK = q.shape
    DV = v.shape[-1]
    nc = S // B_CHUNK
    q, k, log_f = [t.reshape(Bsz, nc, B_CHUNK, H, DK) for t in (q, k, log_f)]
    v = v.reshape(Bsz, nc, B_CHUNK, H, DV)
    b = jnp.cumsum(log_f, axis=2)
    b_last = b[:, :, -1:]
    q_dec = q * jnp.exp(b)
    k_inv = k * jnp.exp(-b)
    k_end = k * jnp.exp(b_last - b)
    scores = jnp.einsum('bnthk,bnshk->bnhts', q_dec, k_inv)
    tri = jnp.tril(jnp.ones((B_CHUNK, B_CHUNK), dtype=bool))
    scores = jnp.where(tri, scores, 0.0)
    o_intra = jnp.einsum('bnhts,bnshv->bnthv', scores, v)

    def step(state, inp):
        q_c, k_c, v_c, dec_c = inp
        o_c = jnp.einsum('bthk,bhkv->bthv', q_c, state)
        state = state * dec_c[:, 0, :, :, None] + jnp.einsum('bshk,bshv->bhkv', k_c, v_c)
        return state, o_c

    xs = tuple(jnp.moveaxis(t, 1, 0) for t in (q_dec, k_end, v, jnp.exp(b_last)))
    s0 = jnp.zeros((Bsz, H, DK, DV), jnp.float32)
    _, o_inter = lax.scan(step, s0, xs)
    o = o_intra + jnp.moveaxis(o_inter, 0, 1)
    return o.reshape(Bsz, S, H, DV)


def _hgrn2(q, f_fwd, f_bwd, i, g, lb_fwd, lb_bwd, g_out):
    Bsz, S, _ = q.shape
    dt = q.dtype

    def heads(t, d):
        return t.astype(jnp.float32).reshape(Bsz, S, B_HEADS, d)

    def gates(z, lb):
        lb = lb.astype(jnp.float32).reshape(B_HEADS, B_DK)
        zh = heads(z, B_DK)
        f = lb + (1.0 - lb) * jax.nn.sigmoid(zh)
        log_f = jnp.log(jnp.maximum(f, TINY))
        key = (1.0 - lb) * jax.nn.sigmoid(-zh)
        return log_f, key

    qh = heads(q, B_DK)
    vh = heads(i, B_DV)
    lf_f, k_f = gates(f_fwd, lb_fwd)
    lf_b, k_b = gates(f_bwd, lb_bwd)
    o_f = _gated_scan(qh, k_f, vh, lf_f)
    flip = lambda t: jnp.flip(t, axis=1)
    o_b = flip(_gated_scan(flip(qh), flip(k_b), flip(vh), flip(lf_b)))
    o = _rmsnorm(o_f + o_b, g_out) * jax.nn.silu(heads(g, B_DV))
    return o.reshape(Bsz, S, B_HEADS * B_DV).astype(dt)


def _window_gqa(q, k, v, rel_bias, sink):
    Bsz, S, _ = q.shape
    nb = S // C_BLOCK
    G = C_HEADS // C_KV_HEADS
    span = 3 * C_BLOCK
    q = q.reshape(Bsz, nb, C_BLOCK, C_KV_HEADS, G, C_DH)

    def band(t):
        t = t.reshape(Bsz, S, C_KV_HEADS, C_DH)
        t = jnp.pad(t, ((0, 0), (C_BLOCK, C_BLOCK), (0, 0), (0, 0)))
        t = t.reshape(Bsz, nb + 2, C_BLOCK, C_KV_HEADS, C_DH)
        return jnp.concatenate([t[:, :-2], t[:, 1:-1], t[:, 2:]], axis=2)

    kb, vb = band(k), band(v)
    rel = jnp.arange(span)[None, :] - C_BLOCK - jnp.arange(C_BLOCK)[:, None]
    bias = rel_bias.astype(jnp.float32)[_t5_bucket(rel)]
    bias = jnp.transpose(bias, (2, 0, 1)).reshape(C_KV_HEADS, G, C_BLOCK, span)
    key_pos = (jnp.arange(nb)[:, None] - 1) * C_BLOCK + jnp.arange(span)[None, :]
    valid = (jnp.abs(rel) <= C_WINDOW)[None] & ((key_pos >= 0) & (key_pos < S))[:, None, :]
    s = jnp.einsum('bnqkgd,bnskd->bnkgqs', q, kb).astype(jnp.float32) * (C_DH ** -0.5) + bias
    s = jnp.where(valid[None, :, None, None], s, MASK_VALUE)
    sink_l = sink.astype(jnp.float32).reshape(C_KV_HEADS, G)[:, :, None, None]
    m = jnp.maximum(jnp.max(s, axis=-1, keepdims=True), sink_l)
    p = jnp.exp(s - m)
    p = p / (jnp.sum(p, axis=-1, keepdims=True) + jnp.exp(sink_l - m))
    o = jnp.einsum('bnkgqs,bnskd->bnqkgd', p.astype(v.dtype), vb)
    return o.reshape(Bsz, S, C_HEADS * C_DH)


def _cross(h, mem_n, wq, wkv, wo):
    Bsz, S, _ = h.shape
    q = (h @ wq).reshape(Bsz, S, X_HEADS, X_DH)
    kv = (mem_n @ wkv).reshape(Bsz, mem_n.shape[1], 2, X_HEADS, X_DH)
    s = jnp.einsum('bqhd,bkhd->bhqk', q, kv[:, :, 0]).astype(jnp.float32) * (X_DH ** -0.5)
    p = jax.nn.softmax(s, axis=-1).astype(h.dtype)
    o = jnp.einsum('bhqk,bkhd->bqhd', p, kv[:, :, 1]).reshape(Bsz, S, X_HEADS * X_DH)
    return o @ wo


def _swiglu(h, w1, w3, w2):
    return (jax.nn.silu(h @ w1) * (h @ w3)) @ w2


def setup_inputs(seed: int = 0) -> dict:
    key = jax.random.key(seed)
    ks = iter(jax.random.split(key, 32))
    f32 = jnp.float32

    def nrm(shape, fan_in):
        return jax.random.normal(next(ks), shape, f32) * (fan_in ** -0.5)

    def gain(shape):
        return 1.0 + 0.02 * jax.random.normal(next(ks), shape, f32)

    L, D = DEPTH, D_MODEL
    return {
        'x': jax.random.normal(next(ks), (BATCH, SEQ, D), f32),
        'mem': jax.random.normal(next(ks), (BATCH, MEM_LEN, D), f32),
        'w_in': nrm((L, D, IN_WIDTH), D),
        'g_mix': gain((L, D)),
        'a_gq': gain((L, A_Q_RANK)),
        'a_gkv': gain((L, A_KV_RANK)),
        'a_wuq': nrm((L, A_Q_RANK, A_HEADS * (A_NOPE + A_ROPE)), A_Q_RANK),
        'a_wukv': nrm((L, A_KV_RANK, A_HEADS * (A_NOPE + A_V)), A_KV_RANK),
        'b_lb': jax.random.normal(next(ks), (2, L, B_HEADS * B_DK), f32),
        'b_gout': gain((L, B_DV)),
        'c_sink': 0.5 * jax.random.normal(next(ks), (L, C_HEADS), f32),
        'rel_bias': 0.5 * jax.random.normal(next(ks), (REL_BUCKETS, C_HEADS), f32),
        'w_br_a': nrm((L, A_HEADS * A_V, D), A_HEADS * A_V),
        'w_br_b': nrm((L, B_HEADS * B_DV, D), B_HEADS * B_DV),
        'w_br_c': nrm((L, C_HEADS * C_DH, D), C_HEADS * C_DH),
        'w_out': nrm((L, D, D), D),
        'g_x': gain((L, D)),
        'g_mem': gain((L, D)),
        'x_wq': nrm((L, D, X_HEADS * X_DH), D),
        'x_wkv': nrm((L, D, 2 * X_HEADS * X_DH), D),
        'x_wo': nrm((L, X_HEADS * X_DH, D), X_HEADS * X_DH),
        'g_ffn': gain((L, D)),
        'f_w1': nrm((L, D, D_FF), D),
        'f_w3': nrm((L, D, D_FF), D),
        'f_w2': nrm((L, D_FF, D), D_FF),
        'g_final': gain((D,)),
    }


def reference(x, mem, w_in, g_mix, a_gq, a_gkv, a_wuq, a_wukv, b_lb, b_gout, c_sink, rel_bias,
              w_br_a, w_br_b, w_br_c, w_out, g_x, g_mem, x_wq, x_wkv, x_wo, g_ffn,
              f_w1, f_w3, f_w2, g_final):
    S = x.shape[1]
    pos = jnp.arange(S, dtype=jnp.int32)
    sm = jax.nn.softmax(b_lb.astype(jnp.float32), axis=1)
    lower_bounds = jnp.cumsum(sm, axis=1) - sm[:, :1]
    for l in range(DEPTH):
        h = _rmsnorm(x, g_mix[l])
        (a_cq, a_ckv, a_kr, b_q, b_ff, b_fb, b_i, b_g,
         c_q, c_k, c_v, gate_a, gate_b, gate_c) = _split_cols(h @ w_in[l], IN_SPLITS)
        y_a = _mla(a_cq, a_ckv, a_kr, a_gq[l], a_gkv[l], a_wuq[l], a_wukv[l], pos)
        y_b = _hgrn2(b_q, b_ff, b_fb, b_i, b_g, lower_bounds[0, l], lower_bounds[1, l], b_gout[l])
        y_c = _window_gqa(c_q, c_k, c_v, rel_bias, c_sink[l])
        merged = (jax.nn.sigmoid(gate_a) * (y_a @ w_br_a[l])
                  + jax.nn.sigmoid(gate_b) * (y_b @ w_br_b[l])
                  + jax.nn.sigmoid(gate_c) * (y_c @ w_br_c[l]))
        x = x + merged @ w_out[l]
        h = _rmsnorm(x, g_x[l])
        x = x + _cross(h, _rmsnorm(mem, g_mem[l]), x_wq[l], x_wkv[l], x_wo[l])
        h = _rmsnorm(x, g_ffn[l])
        x = x + _swiglu(h, f_w1[l], f_w3[l], f_w2[l])
    return _rmsnorm(x, g_final)
```

```cpp
#include <hip/hip_runtime.h>
#include <hip/hip_cooperative_groups.h>
#include <cstdio>
#include <cstdint>
namespace cg = cooperative_groups;
#define DEV __device__ __forceinline__
namespace pg8 {
#define PG8_LAS __attribute__((address_space(3)))
typedef unsigned short bf16_t;
typedef short bf16x8 __attribute__((ext_vector_type(8)));
typedef float f32x4 __attribute__((ext_vector_type(4)));
typedef unsigned u32x4 __attribute__((ext_vector_type(4)));
constexpr int BM = 256, BK = 64, HALF = 128, HTB = HALF * BK * 2  , STAGE_BYTES = 8 * HTB, NXCD = 8, WGM = 8;

__host__ __device__ __forceinline__ int lds_byte(int r, int c) { const int st = (r >> 4) * 2 + (c >> 5), rr = r & 15, cc = c & 31, ob = rr * 64 + cc * 2; return st * 1024 + (ob ^ (((ob >> 9) & 1) << 5)); }
__host__ __device__ __forceinline__ void stage_rc(int b, int& R, int& C) { const int st = b / 1024, sb = b % 1024, swz = sb ^ (((sb >> 9) & 1) << 5); R = (st >> 1) * 16 + swz / 64; C = (st & 1) * 32 + (swz % 64) / 2; }
__host__ __device__ __forceinline__ int perm32(int rho) { const int n = rho >> 4, i = rho & 15; return 8 * (i >> 2) + 4 * n + (i & 3); }

struct Unit { int pm, pn; };
struct Gemm { const bf16_t* A; const bf16_t* Bt; int M, N, K, lda, ldb; };

struct StaticOrder {
    int nM, nN, nwg, G, c;
    __host__ __device__ void init(int M, int N, int G_, int c_) { nM = M / BM; nN = N / BM; nwg = nM * nN; G = G_; c = c_; }
    __host__ __device__ bool next(int i, Unit& u) const {
        const long L = (long)i * G + c; if (L >= nwg) return false;
        int wgid = (int)L; { const int q = nwg / NXCD, r = nwg % NXCD, xcd = wgid % NXCD, off = wgid / NXCD; wgid = (xcd < r ? xcd * (q + 1) : r * (q + 1) + (xcd - r) * q) + off; }
        const int nig = WGM * nN, gid = wgid / nig, fm = gid * WGM, gsz = (nM - fm) < WGM ? (nM - fm) : WGM;
        u.pm = fm + ((wgid % nig) % gsz); u.pn = (wgid % nig) / gsz; return true;
    }
    __device__ __forceinline__ void a_ready(const Unit&) const {}
    __device__ __forceinline__ void done(const Unit&) const {}
};

__device__ __forceinline__ unsigned cvt_pk_bf16(float lo, float hi) { unsigned r; asm volatile("v_cvt_pk_bf16_f32 %0, %1, %2" : "=v"(r) : "v"(lo), "v"(hi)); return r; }
typedef float f32x2 __attribute__((ext_vector_type(2)));
template <class Epi, class Sched, bool ALIGN_EPI = false, bool SP2 = false>
__device__ __forceinline__ void gemm_phase(PG8_LAS unsigned char* lds, const Gemm g, const Sched& S, const Epi& E) {
    int tid_ = threadIdx.x; asm volatile("" : "+v"(tid_)); const int tid = tid_, wid = __builtin_amdgcn_readfirstlane(tid >> 6), lane = tid & 63, wr = wid >> 2, wc = wid & 3, fr = lane & 15, fq = lane >> 4;
    const int K = g.K, nt = K / BK;
    unsigned voffA[2], voffB[2];
#pragma unroll
    for (int i = 0; i < 2; ++i) { int R, C; stage_rc(tid * 16 + i * 8192, R, C); const int Rb = Epi::PERM ? ((R & ~31) + perm32(R & 31)) : R;
        voffA[i] = (unsigned)(R * g.lda + C) * 2u; voffB[i] = (unsigned)(Rb * g.ldb + C) * 2u; }
    const size_t kstep = (size_t)(BK * 2);
    const size_t hstepA = (size_t)HALF * g.lda * 2, hstepB = (size_t)HALF * g.ldb * 2;
    const size_t tstepA = 2 * hstepA, tstepB = 2 * hstepB;
    const unsigned ldsw = (unsigned)wid * 1024u;
    const int aoff = lds_byte(wr * 64 + fr, fq * 8), boff = lds_byte(wc * 32 + fr, fq * 8);
#define PG8_SA(b, h) (((b) * 2 + (h)) * HTB)
#define PG8_SB(b, h) ((4 + (b) * 2 + (h)) * HTB)
#define PG8_STAGE(bufoff, gbase, voff) do { _Pragma("unroll") for (int _i = 0; _i < 2; ++_i) \
        __builtin_amdgcn_global_load_lds((const unsigned*)((const char*)(gbase) + (voff)[_i]), (PG8_LAS unsigned*)(lds + (bufoff) + ldsw + _i * 8192), 16, 0, 0); } while (0)
#define PG8_LDA(dst, b, h) do { _Pragma("unroll") for (int m = 0; m < 4; ++m) _Pragma("unroll") for (int k = 0; k < 2; ++k) dst[m][k] = *(const PG8_LAS bf16x8*)(lds + PG8_SA(b, h) + aoff + m * 2048 + k * 1024); } while (0)
#define PG8_LDB(dst, b, h) do { _Pragma("unroll") for (int n = 0; n < 2; ++n) _Pragma("unroll") for (int k = 0; k < 2; ++k) dst[n][k] = *(const PG8_LAS bf16x8*)(lds + PG8_SB(b, h) + boff + n * 2048 + k * 1024); } while (0)
#define PG8_MMA(ai, bj, At, Bt) do { __builtin_amdgcn_s_setprio(1); _Pragma("unroll") for (int m = 0; m < 4; ++m) _Pragma("unroll") for (int n = 0; n < 2; ++n) _Pragma("unroll") for (int k = 0; k < 2; ++k) \
        acc[ai][bj][m][n] = __builtin_amdgcn_mfma_f32_16x16x32_bf16(Bt[n][k], At[m][k], acc[ai][bj][m][n], 0, 0, 0); __builtin_amdgcn_s_setprio(0); } while (0)
#define PG8_WAIT_V(n) asm volatile("s_waitcnt vmcnt(" #n ")" ::: "memory")
#define PG8_WAIT_L(n) asm volatile("s_waitcnt lgkmcnt(" #n ")" ::: "memory")
#define PG8_BAR __builtin_amdgcn_s_barrier()
#define PG8_SCHED __builtin_amdgcn_sched_barrier(0)
    Unit cur, nxt; int ui = 0;
    if (!S.next(0, cur)) return;
    f32x4 acc[2][2][4][2];
#pragma unroll
    for (int a = 0; a < 2; ++a)
#pragma unroll
        for (int b = 0; b < 2; ++b)
#pragma unroll
            for (int m = 0; m < 4; ++m)
#pragma unroll
                for (int n = 0; n < 2; ++n) acc[a][b][m][n] = (f32x4){0.f, 0.f, 0.f, 0.f};
    bf16x8 At[4][2], B0[2][2], B1[2][2];
    const char* cA = (const char*)g.A + (size_t)cur.pm * tstepA; const char* cB = (const char*)g.Bt + (size_t)cur.pn * tstepB;
    S.a_ready(cur);
    if constexpr (SP2) {
        PG8_STAGE(PG8_SB(0, 0), cB, voffB); PG8_STAGE(PG8_SB(0, 1), cB + hstepB, voffB); PG8_STAGE(PG8_SA(0, 0), cA, voffA); PG8_STAGE(PG8_SA(0, 1), cA + hstepA, voffA);
        if (wr == 1) PG8_BAR;
        PG8_WAIT_V(2); PG8_BAR;
        PG8_STAGE(PG8_SB(1, 0), cB + kstep, voffB); PG8_STAGE(PG8_SA(1, 0), cA + kstep, voffA); PG8_STAGE(PG8_SB(1, 1), cB + hstepB + kstep, voffB);
        PG8_WAIT_V(6); PG8_BAR;
    } else {
        PG8_STAGE(PG8_SB(0, 0), cB, voffB); PG8_STAGE(PG8_SA(0, 0), cA, voffA); PG8_STAGE(PG8_SB(0, 1), cB + hstepB, voffB); PG8_STAGE(PG8_SA(0, 1), cA + hstepA, voffA);
        if (wr == 1) PG8_BAR;
        PG8_WAIT_V(4); PG8_BAR;
        PG8_STAGE(PG8_SB(1, 0), cB + kstep, voffB); PG8_STAGE(PG8_SA(1, 0), cA + kstep, voffA); PG8_STAGE(PG8_SB(1, 1), cB + hstepB + kstep, voffB);
        PG8_WAIT_V(6); PG8_BAR;
    }
    for (;;) {
        const bool has_next = S.next(ui + 1, nxt);
        const char* nA = has_next ? (const char*)g.A + (size_t)nxt.pm * tstepA : cA; const char* nB = has_next ? (const char*)g.Bt + (size_t)nxt.pn * tstepB : cB;
        for (int t = 0; t < nt; t += 2) {
            const bool last = (t == nt - 2);
            const char* a1 = cA + (size_t)(t + 1) * kstep;
            const char* a2 = last ? nA : cA + (size_t)(t + 2) * kstep; const char* b2 = last ? nB : cB + (size_t)(t + 2) * kstep;
            const char* a3 = a2 + kstep; const char* b3 = b2 + kstep;
            if (last && has_next) S.a_ready(nxt);
            if constexpr (SP2) {
            PG8_LDB(B0, 0, 0); PG8_LDB(B1, 0, 1); PG8_SCHED; PG8_LDA(At, 0, 0); PG8_STAGE(PG8_SA(1, 1), a1 + hstepA, voffA);
            PG8_WAIT_V(8); PG8_WAIT_L(0); PG8_BAR; PG8_MMA(0, 0, At, B0); PG8_MMA(0, 1, At, B1); PG8_BAR; PG8_SCHED;
            PG8_LDA(At, 0, 1); PG8_STAGE(PG8_SB(0, 0), b2, voffB); PG8_STAGE(PG8_SB(0, 1), b2 + hstepB, voffB); PG8_STAGE(PG8_SA(0, 0), a2, voffA);
            PG8_WAIT_V(8); PG8_WAIT_L(0); PG8_BAR; PG8_MMA(1, 0, At, B0); PG8_MMA(1, 1, At, B1); PG8_BAR; PG8_SCHED;
            PG8_LDB(B0, 1, 0); PG8_LDB(B1, 1, 1); PG8_SCHED; PG8_LDA(At, 1, 0); PG8_STAGE(PG8_SA(0, 1), a2 + hstepA, voffA);
            PG8_WAIT_V(8); PG8_WAIT_L(0); PG8_BAR; PG8_MMA(0, 0, At, B0); PG8_MMA(0, 1, At, B1); PG8_BAR; PG8_SCHED;
            PG8_LDA(At, 1, 1); PG8_STAGE(PG8_SB(1, 0), b3, voffB); PG8_STAGE(PG8_SB(1, 1), b3 + hstepB, voffB); PG8_STAGE(PG8_SA(1, 0), a3, voffA);
            PG8_WAIT_V(8); PG8_WAIT_L(0); PG8_BAR; PG8_MMA(1, 0, At, B0); PG8_MMA(1, 1, At, B1); PG8_BAR; PG8_SCHED;
            } else {
            PG8_LDB(B0, 0, 0); PG8_SCHED; PG8_LDA(At, 0, 0); PG8_STAGE(PG8_SA(1, 1), a1 + hstepA, voffA);
            PG8_WAIT_L(8); PG8_BAR; PG8_WAIT_L(0); PG8_MMA(0, 0, At, B0); PG8_BAR; PG8_SCHED;
            PG8_LDB(B1, 0, 1); PG8_STAGE(PG8_SB(0, 0), b2, voffB);
            PG8_BAR; PG8_WAIT_L(0); PG8_MMA(0, 1, At, B1); PG8_BAR;
            PG8_LDA(At, 0, 1); PG8_STAGE(PG8_SA(0, 0), a2, voffA);
            PG8_BAR; PG8_WAIT_L(0); PG8_MMA(1, 0, At, B0); PG8_BAR; PG8_SCHED;
            PG8_STAGE(PG8_SB(0, 1), b2 + hstepB, voffB);
            PG8_WAIT_V(6); PG8_BAR; PG8_MMA(1, 1, At, B1); PG8_BAR;
            PG8_LDB(B0, 1, 0); PG8_SCHED; PG8_LDA(At, 1, 0); PG8_STAGE(PG8_SA(0, 1), a2 + hstepA, voffA);
            PG8_WAIT_L(8); PG8_BAR; PG8_WAIT_L(0); PG8_MMA(0, 0, At, B0); PG8_BAR; PG8_SCHED;
            PG8_LDB(B1, 1, 1); PG8_STAGE(PG8_SB(1, 0), b3, voffB);
            PG8_BAR; PG8_WAIT_L(0); PG8_MMA(0, 1, At, B1); PG8_BAR;
            PG8_LDA(At, 1, 1); PG8_STAGE(PG8_SA(1, 0), a3, voffA);
            PG8_BAR; PG8_WAIT_L(0); PG8_MMA(1, 0, At, B0); PG8_BAR; PG8_SCHED;
            PG8_STAGE(PG8_SB(1, 1), b3 + hstepB, voffB);
            PG8_WAIT_V(6); PG8_BAR; PG8_MMA(1, 1, At, B1); PG8_BAR;
            }
        }
        if constexpr (ALIGN_EPI) { if (wr == 0) PG8_BAR; }
        if constexpr (!Epi::AFTER_DRAIN) { E(acc, cur, wr, wc, fr, fq); S.done(cur); }
        if (!has_next) break;
#pragma unroll
        for (int a = 0; a < 2; ++a)
#pragma unroll
            for (int b = 0; b < 2; ++b)
#pragma unroll
                for (int m = 0; m < 4; ++m)
#pragma unroll
                    for (int n = 0; n < 2; ++n) acc[a][b][m][n] = (f32x4){0.f, 0.f, 0.f, 0.f};
        cur = nxt; cA = nA; cB = nB; ++ui;
        if constexpr (ALIGN_EPI) { if (wr == 1) PG8_BAR; }
    }
    PG8_WAIT_V(0);
    if constexpr (!ALIGN_EPI) { if (wr == 0) PG8_BAR; }
    PG8_BAR;
    if constexpr (Epi::AFTER_DRAIN) { E.fused(acc, cur, wr, wc, fr, fq, lds, wid, lane); S.done(cur); }
#undef PG8_SA
#undef PG8_SB
#undef PG8_STAGE
#undef PG8_LDA
#undef PG8_LDB
#undef PG8_MMA
#undef PG8_WAIT_V
#undef PG8_WAIT_L
#undef PG8_BAR
#undef PG8_SCHED
}
}
using pg8::bf16_t; using pg8::bf16x8; using pg8::f32x4; using pg8::u32x4; using pg8::Unit;
typedef float f32x16 __attribute__((ext_vector_type(16)));
typedef float f32x2 __attribute__((ext_vector_type(2)));
typedef unsigned u32x2 __attribute__((ext_vector_type(2)));

constexpr int T = 32768, S = 16384, D = 1024, FF = 2816;
constexpr float EPS = 1e-6f, LOG2E = 1.4426950408889634f;
constexpr size_t MiB = 1u << 20;
constexpr size_t WS_XB = 0, WS_W = 64 * MiB, WS_R2 = 120 * MiB, WS_YA = 376 * MiB, WS_YC = 408 * MiB, WS_YB = 440 * MiB, WS_ST = 472 * MiB, WS_MISC = 488 * MiB, WS_END = 512 * MiB;
constexpr size_t W_1B = 0, W_1AC = 8 * MiB, W_1CVT = 11 * MiB, W_G = 12 * MiB, W_UQ = 20 * MiB, W_UK = 21 * MiB, W_UV = 21 * MiB + 512 * 1024, W_BR = 22 * MiB, W_OUT = 25 * MiB,
                 W_XQ = 27 * MiB, W_XK = 29 * MiB, W_XV = 31 * MiB, W_XO = 33 * MiB, W_13 = 35 * MiB, W_2 = 46 * MiB;
constexpr size_t R_BZ = 0, R_ACQ = 0, R_ACKV = 24 * MiB, R_CQ = 40 * MiB, R_CK = 72 * MiB, R_CVT = 80 * MiB, R_QA = 88 * MiB, R_KA = 136 * MiB, R_VAT = 184 * MiB,
                 R_PBR = 0, R_MERGED = 192 * MiB, R_QX = 0, R_OX = 64 * MiB, R_HID = 0;
constexpr size_t M_SS = 0, M_ROPE = 2 * MiB, M_BT = 4 * MiB, M_MEMN = 5 * MiB, M_KX = 7 * MiB, M_VXT = 8 * MiB, M_HD = 9 * MiB, M_BAR = 10 * MiB, M_SS64 = 14 * MiB;
constexpr int LDS_BYTES = 147456;

DEV float bf2f(bf16_t b) { return __uint_as_float((unsigned)b << 16); }
DEV unsigned pk2(float lo, float hi) { return pg8::cvt_pk_bf16(lo, hi); }
typedef __bf16 bf16x2_t __attribute__((ext_vector_type(2)));
DEV unsigned pk2b(float lo, float hi) { const f32x2 v = {lo, hi}; const bf16x2_t b = __builtin_convertvector(v, bf16x2_t); return __builtin_bit_cast(unsigned, b); }
DEV float wave_sum(float v) { _Pragma("unroll")
    for (int o = 1; o < 64; o <<= 1) v += __shfl_xor(v, o);
    return v;
}
DEV float sigmoidf_(float z) { return __builtin_amdgcn_rcpf(1.f + __expf(-z)); }
DEV float rstd_of(const unsigned long long* ss, int row, float invn) { return rsqrtf((float)ss[row] * (1.f / 16777216.f) * invn + EPS); }
DEV void st4(bf16_t* p, f32x4 v) { u32x2 w; w.x = pk2(v[0], v[1]); w.y = pk2(v[2], v[3]); *(u32x2*)p = w; }

#define XB_TMO      128
#define XB_XCNT(j)  (256  + 64 * (j))
#define XB_XSUB(j)  (1280 + 64 * (j))
#define XB_XGEN(j)  (2304 + 64 * (j))
#define XB_TOP      3328
#define XB_TOPGEN   3392
#define XCD_BAR_WORDS 3456
#define XB_SPIN_CAP (1u << 18)

__device__ __forceinline__ unsigned xb_ld(unsigned* p)              { return __hip_atomic_load(p, __ATOMIC_RELAXED, __HIP_MEMORY_SCOPE_AGENT); }
__device__ __forceinline__ unsigned xb_add(unsigned* p, unsigned v) { return __hip_atomic_fetch_add(p, v, __ATOMIC_RELAXED, __HIP_MEMORY_SCOPE_AGENT); }
__device__ __forceinline__ unsigned xb_xcc_id() { return (unsigned)__builtin_amdgcn_s_getreg((3 << 11) | 20) & 0xFu; }
#define XB_SPIN(cond, bar) do { unsigned _sp = 0; while (cond) { __builtin_amdgcn_s_sleep(1); \
    if ((++_sp & 255u) == 0u) { if (xb_ld(&(bar)[XB_TMO])) break; if (_sp > XB_SPIN_CAP) { atomicAdd(&(bar)[XB_TMO], 1u); break; } } } } while (0)

struct XcdBarrier {
    unsigned* bar; unsigned x;
    volatile PG8_LAS unsigned* st;
};

__device__ __forceinline__ XcdBarrier xcd_barrier_post(unsigned* bar, volatile PG8_LAS unsigned* st) {
    XcdBarrier b; b.bar = bar; b.x = xb_xcc_id(); b.st = st;
    if (threadIdx.x == 0) (void)xb_add(&bar[XB_XCNT(b.x)], 1u);
    return b;
}
__device__ __forceinline__ void xcd_barrier_complete(unsigned* bar, unsigned x, unsigned& nloc, unsigned& nx) {
    const unsigned G = gridDim.x * gridDim.y * gridDim.z;
    unsigned sum, cnt, mine, sp = 0u;
    for (;;) {
        sum = 0u; cnt = 0u; mine = 0u;
#pragma unroll
        for (unsigned j = 0; j < 16; ++j) { const unsigned c = xb_ld(&bar[XB_XCNT(j)]); sum += c; cnt += (c > 0u) ? 1u : 0u; mine = (j == x) ? c : mine; }
        if (sum == G) break;
        __builtin_amdgcn_s_sleep(1);
        if ((++sp & 255u) == 0u) { if (xb_ld(&bar[XB_TMO])) break; if (sp > XB_SPIN_CAP) { atomicAdd(&bar[XB_TMO], 1u); break; } }
    }
    nloc = mine > 0u ? mine : 1u; nx = cnt > 0u ? cnt : 1u;
}

__device__ __forceinline__ void xcd_barrier(const XcdBarrier& b) {
    asm volatile("s_waitcnt vmcnt(0)" ::: "memory");
    __syncthreads();
    if (threadIdx.x == 0) {
        unsigned* bar = b.bar;
        __builtin_amdgcn_s_waitcnt(0);
        unsigned nloc = b.st[0], nx = b.st[1];
        if (nloc == 0u) { xcd_barrier_complete(bar, b.x, nloc, nx); b.st[0] = nloc; b.st[1] = nx; }
        const unsigned old = xb_add(&bar[XB_XSUB(b.x)], 1u);
        const unsigned gen = old / nloc;
        if (old + 1u == (gen + 1u) * nloc) {
            __builtin_amdgcn_fence(__ATOMIC_RELEASE, "agent");
            asm volatile("s_waitcnt vmcnt(0)" ::: "memory");
            const unsigned og = xb_add(&bar[XB_TOP], 1u);
            const unsigned tg = og / nx;
            if (og + 1u == (tg + 1u) * nx) xb_add(&bar[XB_TOPGEN], 1u);
            else XB_SPIN(xb_ld(&bar[XB_TOPGEN]) == tg, bar);
            __builtin_amdgcn_fence(__ATOMIC_ACQUIRE, "agent");
            xb_add(&bar[XB_XGEN(b.x)], 1u);
            asm volatile("s_waitcnt vmcnt(0)" ::: "memory");
        } else {
            XB_SPIN(xb_ld(&bar[XB_XGEN(b.x)]) == gen, bar);
            __builtin_amdgcn_fence(__ATOMIC_ACQUIRE, "agent");
            asm volatile("s_waitcnt vmcnt(0)" ::: "memory");
        }
    }
    __syncthreads();
}

#define EPI_ROWS(...) _Pragma("unroll") for (int ai = 0; ai < 2; ++ai) _Pragma("unroll") for (int m = 0; m < 4; ++m) { const int row = u.pm * 256 + ai * 128 + wr * 64 + m * 16 + fr; __VA_ARGS__ }
#define EPI_COLS(...) _Pragma("unroll") for (int bj = 0; bj < 2; ++bj) _Pragma("unroll") for (int n = 0; n < 2; ++n) { const int col = u.pn * 256 + bj * 128 + wc * 32 + n * 16 + 4 * fq; const f32x4 v = acc[ai][bj][m][n]; __VA_ARGS__ }
typedef const f32x4 (&AccT)[2][2][4][2];

DEV unsigned char* launder(unsigned char* p) { unsigned lo = __builtin_amdgcn_readfirstlane((unsigned)(uintptr_t)p), hi = __builtin_amdgcn_readfirstlane((unsigned)((uintptr_t)p >> 32)); asm volatile("" : "+s"(lo), "+s"(hi)); return (unsigned char*)(((uintptr_t)hi << 32) | (uintptr_t)lo); }
typedef unsigned long long u64_t;
#define SSP(w_, i_) ((u64_t*)((w_) + WS_MISC + M_SS64) + (size_t)(i_) * T)
DEV u64_t ss_fix(float v) { return (u64_t)(v * 16777216.f + 0.5f); }
template <bool KMAP> struct EpiRow {
    static constexpr bool PERM = false, AFTER_DRAIN = false;
    unsigned char* ws; size_t off; int ldc; int ssi; float invn; float cs;
    DEV void operator()(AccT acc, const Unit& u, int wr, int wc, int fr, int fq) const {
        unsigned char* w = launder(ws); bf16_t* out = (bf16_t*)(w + off); const u64_t* ss = SSP(w, ssi);
        EPI_ROWS( const float rs = (ssi >= 0 ? rstd_of(ss, row, invn) : 1.f) * cs;
            EPI_COLS( const int oc = KMAP ? ((col >> 6) * 96 + (col & 63)) : col; st4(out + (size_t)row * ldc + oc, v * rs); ) )
    }
};
struct EpiRowP {
    static constexpr bool PERM = true, AFTER_DRAIN = false;
    unsigned char* ws; size_t off; int ldc; int ssi; float invn; float cs;
    DEV void operator()(AccT acc, const Unit& u, int wr, int wc, int fr, int fq) const {
        unsigned char* w = launder(ws); bf16_t* out = (bf16_t*)(w + off); const u64_t* ss = SSP(w, ssi);
        EPI_ROWS( const float rs = (ssi >= 0 ? rstd_of(ss, row, invn) : 1.f) * cs;
            _Pragma("unroll") for (int bj = 0; bj < 2; ++bj) { const f32x4 v0 = acc[ai][bj][m][0] * rs; const f32x4 v1 = acc[ai][bj][m][1] * rs;
                u32x4 o; o.x = pk2(v0[0], v0[1]); o.y = pk2(v0[2], v0[3]); o.z = pk2(v1[0], v1[1]); o.w = pk2(v1[2], v1[3]);
                *(u32x4*)(out + (size_t)row * ldc + u.pn * 256 + bj * 128 + wc * 32 + 8 * fq) = o; } )
    }
};
struct EpiCol {
    static constexpr bool PERM = false, AFTER_DRAIN = false;
    unsigned char* ws; size_t off; int ldc; int ssi; float invn; int rlim;
    DEV void operator()(AccT acc, const Unit& u, int wr, int wc, int fr, int fq) const {
        unsigned char* w = launder(ws); bf16_t* out = (bf16_t*)(w + off); const u64_t* ss = SSP(w, ssi);
        EPI_ROWS( if (row < rlim) {
            EPI_COLS( f32x4 s = {1.f, 1.f, 1.f, 1.f}; if (ssi >= 0) { s[0] = rstd_of(ss, col, invn); s[1] = rstd_of(ss, col + 1, invn); s[2] = rstd_of(ss, col + 2, invn); s[3] = rstd_of(ss, col + 3, invn); }
                st4(out + (size_t)row * ldc + col, v * s); ) } )
    }
};
struct EpiAC {
    static constexpr bool PERM = false, AFTER_DRAIN = false;
    unsigned char* ws; int l;
    DEV void operator()(AccT acc, const Unit& u, int wr, int wc, int fr, int fq) const {
        unsigned char* w = launder(ws); unsigned char* R2 = w + WS_R2;
        bf16_t* acq = (bf16_t*)(R2 + R_ACQ); bf16_t* ackv = (bf16_t*)(R2 + R_ACKV); bf16_t* cq = (bf16_t*)(R2 + R_CQ); bf16_t* ck = (bf16_t*)(R2 + R_CK); bf16_t* ka = (bf16_t*)(R2 + R_KA);
        const u64_t* ssm = SSP(w, l * 5); u64_t* ssq = SSP(w, l * 5 + 1); u64_t* sskv = SSP(w, l * 5 + 2);
        const float* rc = (const float*)(w + WS_MISC + M_ROPE); const float* rsn = rc + S * 16; const float cqs = 0.125f * LOG2E;
        const int pn = u.pn;
        EPI_ROWS( const float rs = rstd_of(ssm, row, 1.f / 1024.f);
            if (pn <= 2) { float sq = 0.f;
                EPI_COLS( const f32x4 wv = v * rs;
                    if (pn == 2) { st4(ackv + (size_t)row * 256 + (col - 512), wv); sq += (wv[0] * wv[0] + wv[1] * wv[1]) + (wv[2] * wv[2] + wv[3] * wv[3]); }
                    else if (col < 384) { st4(acq + (size_t)row * 384 + col, wv); sq += (wv[0] * wv[0] + wv[1] * wv[1]) + (wv[2] * wv[2] + wv[3] * wv[3]); }
                    else st4(ck + (size_t)row * 128 + (col - 384), wv); )
                sq += __shfl_xor(sq, 16); sq += __shfl_xor(sq, 32);
                if (fq == 0) atomicAdd((pn == 2 ? sskv : ssq) + row, ss_fix(sq));
            } else if (pn <= 4) { EPI_COLS( st4(cq + (size_t)row * 512 + (col - 768), v * (rs * cqs)); ) }
            else if (wc == 0) {
                const int pos = row & (S - 1); const f32x4 c4 = *(const f32x4*)(rc + pos * 16 + 4 * fq); const f32x4 s4 = *(const f32x4*)(rsn + pos * 16 + 4 * fq);
                const f32x4 x1 = acc[ai][0][m][0] * rs; const f32x4 x2 = acc[ai][0][m][1] * rs; const f32x4 o1 = x1 * c4 - x2 * s4; const f32x4 o2 = x1 * s4 + x2 * c4;
                _Pragma("unroll") for (int h = 0; h < 8; ++h) { st4(ka + (size_t)row * 768 + h * 96 + 64 + 4 * fq, o1); st4(ka + (size_t)row * 768 + h * 96 + 80 + 4 * fq, o2); } } )
    }
};
struct EpiQ {
    static constexpr bool PERM = false, AFTER_DRAIN = false;
    unsigned char* ws; int l;
    DEV void operator()(AccT acc, const Unit& u, int wr, int wc, int fr, int fq) const {
        unsigned char* w = launder(ws); bf16_t* qa = (bf16_t*)(w + WS_R2 + R_QA); const u64_t* ssq = SSP(w, l * 5 + 1);
        const float* rc = (const float*)(w + WS_MISC + M_ROPE); const float* rsn = rc + S * 16; const float qs = 0.10206207261596575f * LOG2E;
        EPI_ROWS( const float rs = rstd_of(ssq, row, 1.f / 384.f) * qs; const int pos = row & (S - 1);
            _Pragma("unroll") for (int bj = 0; bj < 2; ++bj) { const int col0 = u.pn * 256 + bj * 128 + wc * 32; const int g = col0 >> 5;
                f32x4 x1 = acc[ai][bj][m][0] * rs; f32x4 x2 = acc[ai][bj][m][1] * rs;
                if (g % 3 == 2) { const f32x4 c4 = *(const f32x4*)(rc + pos * 16 + 4 * fq); const f32x4 s4 = *(const f32x4*)(rsn + pos * 16 + 4 * fq);
                    const f32x4 o1 = x1 * c4 - x2 * s4; const f32x4 o2 = x1 * s4 + x2 * c4; x1 = o1; x2 = o2; }
                st4(qa + (size_t)row * 768 + col0 + 4 * fq, x1); st4(qa + (size_t)row * 768 + col0 + 16 + 4 * fq, x2); } )
    }
};
struct EpiMerge {
    static constexpr bool PERM = false, AFTER_DRAIN = false;
    unsigned char* ws; int l;
    DEV void operator()(AccT acc, const Unit& u, int wr, int wc, int fr, int fq) const {
        unsigned char* w = launder(ws); bf16_t* merged = (bf16_t*)(w + WS_R2 + R_MERGED); const bf16_t* pbr = (const bf16_t*)(w + WS_R2 + R_PBR); const u64_t* ssm = SSP(w, l * 5);
        const int mc = u.pn * 64 + wc * 16 + 4 * fq;
        EPI_ROWS( const float rs = rstd_of(ssm, row, 1.f / 1024.f); f32x4 o = {0.f, 0.f, 0.f, 0.f};
            _Pragma("unroll") for (int s = 0; s < 3; ++s) { const f32x4 g = acc[ai][s >> 1][m][s & 1] * rs; const u32x2 pw = *(const u32x2*)(pbr + (size_t)row * 3072 + s * 1024 + mc);
                o[0] += sigmoidf_(g[0]) * __uint_as_float(pw.x << 16); o[1] += sigmoidf_(g[1]) * __uint_as_float(pw.x & 0xffff0000u);
                o[2] += sigmoidf_(g[2]) * __uint_as_float(pw.y << 16); o[3] += sigmoidf_(g[3]) * __uint_as_float(pw.y & 0xffff0000u); }
            st4(merged + (size_t)row * 1024 + mc, o); )
    }
};
struct EpiRes {
    static constexpr bool PERM = false, AFTER_DRAIN = false;
    unsigned char* ws; const float* Xin; float* X; int ssi;
    DEV void operator()(AccT acc, const Unit& u, int wr, int wc, int fr, int fq) const {
        unsigned char* w = launder(ws); bf16_t* xb = (bf16_t*)(w + WS_XB); u64_t* sso = SSP(w, ssi);
        EPI_ROWS( float sq = 0.f;
            EPI_COLS( const size_t xo = (size_t)row * 1024 + col; const f32x4 wv = *(const f32x4*)(Xin + xo) + v; *(f32x4*)(X + xo) = wv; st4(xb + (size_t)row * 1024 + col, wv);
                sq += (wv[0] * wv[0] + wv[1] * wv[1]) + (wv[2] * wv[2] + wv[3] * wv[3]); )
            sq += __shfl_xor(sq, 16); sq += __shfl_xor(sq, 32); if (fq == 0) atomicAdd(sso + row, ss_fix(sq)); )
    }
};
struct EpiFfn {
    static constexpr bool PERM = true, AFTER_DRAIN = false;
    unsigned char* ws; int ssi;
    DEV void operator()(AccT acc, const Unit& u, int wr, int wc, int fr, int fq) const {
        unsigned char* w = launder(ws); bf16_t* hid = (bf16_t*)(w + WS_R2 + R_HID); const u64_t* ss = SSP(w, ssi);
        EPI_ROWS( const float rs = rstd_of(ss, row, 1.f / 1024.f); f32x4 o[2];
            _Pragma("unroll") for (int n = 0; n < 2; ++n) { const f32x4 a = acc[ai][0][m][n] * rs; const f32x4 b = acc[ai][1][m][n] * rs;
                _Pragma("unroll") for (int i = 0; i < 4; ++i) o[n][i] = a[i] * sigmoidf_(a[i]) * b[i]; }
            u32x4 ow; ow.x = pk2(o[0][0], o[0][1]); ow.y = pk2(o[0][2], o[0][3]); ow.z = pk2(o[1][0], o[1][1]); ow.w = pk2(o[1][2], o[1][3]);
            *(u32x4*)(hid + (size_t)row * FF + u.pn * 128 + wc * 32 + 8 * fq) = ow; )
    }
};
template <class Epi> DEV void run_gemm(unsigned char* lds, const bf16_t* A, int lda, const bf16_t* Bt, int ldb, int M, int N, int K, const Epi& E) {
    pg8::Gemm g{A, Bt, M, N, K, lda, ldb}; pg8::StaticOrder So; So.init(M, N, (int)gridDim.x, (int)blockIdx.x);
    pg8::gemm_phase<Epi, pg8::StaticOrder, true, true>((PG8_LAS unsigned char*)lds, g, So, E);
}
template <int DQK, int DV, int NDP, int MODE, bool PF>
DEV void attn_unit(unsigned char* lds, const bf16_t* Q, int ldq, const bf16_t* K, int ldk, const bf16_t* VT, int ldvt, bf16_t* O, int ldo,
                   int kt0, int ntiles, int qpos0, const float* biasg, float sinkl2) {
    constexpr int KP = DQK + 8, VP = 72, DVW = DV / NDP, NKC = DQK / 8, KCH = 64 * NKC, VCH = DV * 8, NKL = (KCH + 511) / 512, NVL = (VCH + 511) / 512, ND0 = DQK / 16, NDB = DVW / 32;
    int tid_ = threadIdx.x; asm volatile("" : "+v"(tid_)); const int tid = tid_, lane = tid & 63, wid = __builtin_amdgcn_readfirstlane(tid >> 6), r32 = lane & 31, hi = lane >> 5;
    const int qg = wid / NDP, dp = wid % NDP;
    bf16_t* Kt = (bf16_t*)lds; bf16_t* Vt = Kt + 64 * KP; float* bt = (float*)(Vt + DV * VP);
    u32x4 kreg[NKL], vreg[NVL];
#define ATT_GLOAD(kt_) do { \
    _Pragma("unroll") for (int i = 0; i < NKL; ++i) { const int id = tid + 512 * i; if (KCH % 512 == 0 || id < KCH) { const int row = id / NKC, cc = id % NKC; kreg[i] = *(const u32x4*)(K + (size_t)((kt_) + row) * ldk + cc * 8); } } \
    _Pragma("unroll") for (int i = 0; i < NVL; ++i) { const int id = tid + 512 * i; if (VCH % 512 == 0 || id < VCH) { const int row = id >> 3, cc = id & 7; vreg[i] = *(const u32x4*)(VT + (size_t)row * ldvt + (kt_) + cc * 8); } } } while (0)
#define ATT_LSTORE() do { \
    _Pragma("unroll") for (int i = 0; i < NKL; ++i) { const int id = tid + 512 * i; if (KCH % 512 == 0 || id < KCH) { const int row = id / NKC, cc = id % NKC; *(u32x4*)(Kt + row * KP + cc * 8) = kreg[i]; } } \
    _Pragma("unroll") for (int i = 0; i < NVL; ++i) { const int id = tid + 512 * i; if (VCH % 512 == 0 || id < VCH) { const int row = id >> 3, cc = id & 7; *(u32x4*)(Vt + row * VP + cc * 8) = vreg[i]; } } } while (0)
    if (PF) ATT_GLOAD(kt0);
    bf16x8 qf[ND0];
#pragma unroll
    for (int d0 = 0; d0 < ND0; ++d0) qf[d0] = *(const bf16x8*)(Q + (size_t)(qg * 32 + r32) * ldq + d0 * 16 + hi * 8);
    float mrun = (MODE == 1) ? sinkl2 : -1e30f, lrun = (MODE == 1 && hi == 0) ? 1.f : 0.f;
    f32x16 o[NDB];
#pragma unroll
    for (int i = 0; i < NDB; ++i)
#pragma unroll
        for (int r = 0; r < 16; ++r) o[i][r] = 0.f;
    const int krow = 16 * (r32 >> 4) + 8 * ((r32 >> 2) & 1) + 4 * ((r32 >> 3) & 1) + (r32 & 3);
    const int qabs = qpos0 + qg * 32 + r32;
    for (int ti = 0; ti < ntiles; ++ti) {
        const int kt = kt0 + ti * 64;
        __syncthreads();
        if (!PF) ATT_GLOAD(kt);
        ATT_LSTORE();
        if (MODE == 1 && ti == 0) { for (int i = tid; i < 257; i += 512) bt[i] = biasg[i]; }
        __syncthreads();
        if (PF && ti + 1 < ntiles) ATT_GLOAD(kt + 64);
        bool skip = false;
        if (MODE == 1) { const int qlo = qpos0 + qg * 32; skip = (kt > qlo + 31 + 128) || (kt + 63 < qlo - 128); }
        if (!skip) {
            f32x16 p0, p1;
#pragma unroll
            for (int r = 0; r < 16; ++r) { p0[r] = 0.f; p1[r] = 0.f; }
#pragma unroll
            for (int d0 = 0; d0 < ND0; ++d0) {
                const bf16x8 k0 = *(const bf16x8*)(Kt + krow * KP + d0 * 16 + hi * 8), k1 = *(const bf16x8*)(Kt + (32 + krow) * KP + d0 * 16 + hi * 8);
                p0 = __builtin_amdgcn_mfma_f32_32x32x16_bf16(k0, qf[d0], p0, 0, 0, 0);
                p1 = __builtin_amdgcn_mfma_f32_32x32x16_bf16(k1, qf[d0], p1, 0, 0, 0);
            }
            if (MODE == 1) {
#pragma unroll
                for (int r = 0; r < 16; ++r) { const int rel0 = kt + 16 * (r >> 3) + 8 * hi + (r & 7) - qabs, rel1 = rel0 + 32;
                    const int i0 = min(max(rel0 + 128, 0), 256), i1 = min(max(rel1 + 128, 0), 256);
                    p0[r] = (rel0 >= -128 && rel0 <= 128) ? p0[r] + bt[i0] : -1e30f; p1[r] = (rel1 >= -128 && rel1 <= 128) ? p1[r] + bt[i1] : -1e30f; }
            }
            float mx = fmaxf(p0[0], p1[0]);
#pragma unroll
            for (int r = 1; r < 16; ++r) mx = fmaxf(mx, fmaxf(p0[r], p1[r]));
            mx = fmaxf(mx, __shfl_xor(mx, 32));
            const float mnew = fmaxf(mrun, mx), alpha = __builtin_amdgcn_exp2f(mrun - mnew); mrun = mnew;
            float rsum = 0.f;
#pragma unroll
            for (int r = 0; r < 16; ++r) { p0[r] = __builtin_amdgcn_exp2f(p0[r] - mnew); p1[r] = __builtin_amdgcn_exp2f(p1[r] - mnew); rsum += p0[r] + p1[r]; }
            lrun = lrun * alpha + rsum;
#pragma unroll
            for (int i = 0; i < NDB; ++i)
#pragma unroll
                for (int r = 0; r < 16; ++r) o[i][r] *= alpha;
            bf16x8 pb[4];
#pragma unroll
            for (int ks = 0; ks < 4; ++ks) { u32x4 w;
                if (ks < 2) { w.x = pk2(p0[8 * ks + 0], p0[8 * ks + 1]); w.y = pk2(p0[8 * ks + 2], p0[8 * ks + 3]); w.z = pk2(p0[8 * ks + 4], p0[8 * ks + 5]); w.w = pk2(p0[8 * ks + 6], p0[8 * ks + 7]); }
                else { const int k2 = ks - 2; w.x = pk2(p1[8 * k2 + 0], p1[8 * k2 + 1]); w.y = pk2(p1[8 * k2 + 2], p1[8 * k2 + 3]); w.z = pk2(p1[8 * k2 + 4], p1[8 * k2 + 5]); w.w = pk2(p1[8 * k2 + 6], p1[8 * k2 + 7]); }
                pb[ks] = __builtin_bit_cast(bf16x8, w); }
#pragma unroll
            for (int db = 0; db < NDB; ++db)
#pragma unroll
                for (int ks = 0; ks < 4; ++ks) {
                    const bf16x8 vf = *(const bf16x8*)(Vt + (dp * DVW + db * 32 + r32) * VP + ks * 16 + hi * 8);
                    o[db] = __builtin_amdgcn_mfma_f32_32x32x16_bf16(vf, pb[ks], o[db], 0, 0, 0);
                }
        }
    }
    const float ltot = lrun + __shfl_xor(lrun, 32), inv = 1.f / ltot;
    bf16_t* orow = O + (size_t)(qg * 32 + r32) * ldo + dp * DVW;
#pragma unroll
    for (int db = 0; db < NDB; ++db)
#pragma unroll
        for (int g4 = 0; g4 < 4; ++g4) { f32x4 w = {o[db][4 * g4] * inv, o[db][4 * g4 + 1] * inv, o[db][4 * g4 + 2] * inv, o[db][4 * g4 + 3] * inv}; st4(orow + db * 32 + 8 * g4 + 4 * hi, w); }
}
DEV float max3f(float a, float b, float c) { float r; asm("v_max3_f32 %0, %1, %2, %3" : "=v"(r) : "v"(a), "v"(b), "v"(c)); return r; }
DEV float hmax32(float x) { auto rr = __builtin_amdgcn_permlane32_swap(__float_as_uint(x), __float_as_uint(x), false, false); return fmaxf(__uint_as_float(rr[0]), __uint_as_float(rr[1])); }
DEV float hsum32(float x) { auto rr = __builtin_amdgcn_permlane32_swap(__float_as_uint(x), __float_as_uint(x), false, false); return __uint_as_float(rr[0]) + __uint_as_float(rr[1]); }
DEV void mla_unit(PG8_LAS unsigned char* lds, const bf16_t* Q, const bf16_t* K, const bf16_t* VT, bf16_t* O) {
    int tid_ = threadIdx.x; asm volatile("" : "+v"(tid_)); const int tid = tid_, lane = tid & 63, wid = __builtin_amdgcn_readfirstlane(tid >> 6), r32 = lane & 31, hi = lane >> 5;
    constexpr int BUFB = 22528, KBY = 13312, NT = S / 64;
    int kofs[2], vofs[2];
#pragma unroll
    for (int i = 0; i < 2; ++i) { const int idx = (wid + 8 * i) * 64 + lane; { const int row = idx / 13, cc = idx % 13; kofs[i] = row * 768 + (cc < 12 ? cc : 11) * 8; }
        { const int row = idx / 9, cc = idx % 9; vofs[i] = row * T + (cc < 8 ? cc : 7) * 8; } }
#define MLA_DMA(kt_, b_) do { \
    _Pragma("unroll") for (int i = 0; i < 2; ++i) if (wid + 8 * i < 13) __builtin_amdgcn_global_load_lds((const unsigned*)(K + (size_t)(kt_) * 768 + kofs[i]), (PG8_LAS unsigned*)(lds + (b_) * BUFB + (wid + 8 * i) * 1024), 16, 0, 0); \
    _Pragma("unroll") for (int i = 0; i < 2; ++i) if (wid + 8 * i < 9) __builtin_amdgcn_global_load_lds((const unsigned*)(VT + (kt_) + vofs[i]), (PG8_LAS unsigned*)(lds + (b_) * BUFB + KBY + (wid + 8 * i) * 1024), 16, 0, 0); } while (0)
    MLA_DMA(0, 0);
    bf16x8 qf[2][6];
#pragma unroll
    for (int sb = 0; sb < 2; ++sb)
#pragma unroll
        for (int d0 = 0; d0 < 6; ++d0) qf[sb][d0] = *(const bf16x8*)(Q + (size_t)(wid * 64 + sb * 32 + r32) * 768 + d0 * 16 + hi * 8);
    f32x16 negm[2], o[2][2]; float mhat[2] = {0.f, 0.f}, lrun[2] = {0.f, 0.f};
#pragma unroll
    for (int sb = 0; sb < 2; ++sb)
#pragma unroll
        for (int r = 0; r < 16; ++r) { negm[sb][r] = 0.f; o[sb][0][r] = 0.f; o[sb][1][r] = 0.f; }
    const int krow = 16 * (r32 >> 4) + 8 * ((r32 >> 2) & 1) + 4 * ((r32 >> 3) & 1) + (r32 & 3);
    const int kfo = (krow * 13 + hi) * 16, vfo = KBY + (r32 * 9 + hi) * 16;
    __syncthreads();
    for (int t = 0; t < NT; ++t) {
        const int cur = t & 1;
        if (t + 1 < NT) MLA_DMA((t + 1) * 64, cur ^ 1);
        PG8_LAS const unsigned char* Kb = lds + cur * BUFB;
        bf16x8 pb[2][4];
#pragma unroll
        for (int sb = 0; sb < 2; ++sb) {
            f32x16 p0, p1; int kfo_ = kfo; asm volatile("" : "+v"(kfo_));
#pragma unroll
            for (int d0 = 0; d0 < 6; ++d0) {
                const bf16x8 k0 = *(PG8_LAS const bf16x8*)(Kb + kfo_ + d0 * 32), k1 = *(PG8_LAS const bf16x8*)(Kb + kfo_ + 32 * 208 + d0 * 32);
                p0 = __builtin_amdgcn_mfma_f32_32x32x16_bf16(k0, qf[sb][d0], d0 == 0 ? negm[sb] : p0, 0, 0, 0);
                p1 = __builtin_amdgcn_mfma_f32_32x32x16_bf16(k1, qf[sb][d0], d0 == 0 ? negm[sb] : p1, 0, 0, 0);
            }
            asm volatile("s_nop 15\n\ts_nop 7" : "+v"(p0), "+v"(p1));
            float mx = max3f(p0[0], p1[0], p0[1]);
#pragma unroll
            for (int r = 1; r < 15; ++r) mx = max3f(mx, p1[r], p0[r + 1]);
            mx = hmax32(fmaxf(mx, p1[15]));
            if (t == 0 || __any(mx > 8.f)) {
                const float dl = (t == 0) ? mx : fmaxf(mx, 0.f); mhat[sb] += dl;
#pragma unroll
                for (int r = 0; r < 16; ++r) { p0[r] -= dl; p1[r] -= dl; negm[sb][r] = -mhat[sb]; }
                if (t != 0) { const float f = __builtin_amdgcn_exp2f(-dl); lrun[sb] *= f;
#pragma unroll
                    for (int r = 0; r < 16; ++r) { o[sb][0][r] *= f; o[sb][1][r] *= f; } }
            }
            float rsum = 0.f;
#pragma unroll
            for (int r = 0; r < 16; ++r) { p0[r] = __builtin_amdgcn_exp2f(p0[r]); p1[r] = __builtin_amdgcn_exp2f(p1[r]); rsum += p0[r] + p1[r]; }
            lrun[sb] += rsum;
#pragma unroll
            for (int ks = 0; ks < 4; ++ks) { u32x4 w;
                if (ks < 2) { w.x = pk2(p0[8 * ks + 0], p0[8 * ks + 1]); w.y = pk2(p0[8 * ks + 2], p0[8 * ks + 3]); w.z = pk2(p0[8 * ks + 4], p0[8 * ks + 5]); w.w = pk2(p0[8 * ks + 6], p0[8 * ks + 7]); }
                else { const int k2 = ks - 2; w.x = pk2(p1[8 * k2 + 0], p1[8 * k2 + 1]); w.y = pk2(p1[8 * k2 + 2], p1[8 * k2 + 3]); w.z = pk2(p1[8 * k2 + 4], p1[8 * k2 + 5]); w.w = pk2(p1[8 * k2 + 6], p1[8 * k2 + 7]); }
                pb[sb][ks] = __builtin_bit_cast(bf16x8, w); }
        }
#pragma unroll
        for (int db = 0; db < 2; ++db)
#pragma unroll
            for (int ks = 0; ks < 4; ++ks) {
                const bf16x8 vf = *(PG8_LAS const bf16x8*)(Kb + vfo + db * 32 * 144 + ks * 32);
                o[0][db] = __builtin_amdgcn_mfma_f32_32x32x16_bf16(vf, pb[0][ks], o[0][db], 0, 0, 0);
                o[1][db] = __builtin_amdgcn_mfma_f32_32x32x16_bf16(vf, pb[1][ks], o[1][db], 0, 0, 0);
            }
        __syncthreads();
    }
#pragma unroll
    for (int sb = 0; sb < 2; ++sb) {
        const float inv = 1.f / hsum32(lrun[sb]);
        bf16_t* orow = O + (size_t)(wid * 64 + sb * 32 + r32) * 512;
#pragma unroll
        for (int db = 0; db < 2; ++db)
#pragma unroll
            for (int g4 = 0; g4 < 4; ++g4) { f32x4 w = {o[sb][db][4 * g4] * inv, o[sb][db][4 * g4 + 1] * inv, o[sb][db][4 * g4 + 2] * inv, o[sb][db][4 * g4 + 3] * inv}; st4(orow + db * 32 + 8 * g4 + 4 * hi, w); }
    }
#undef MLA_DMA
}
typedef short s16x4 __attribute__((ext_vector_type(4)));
template <int PASS>
DEV void hgrn_task(unsigned char* lds, int task, int l, const bf16_t* BZ, float* E, float* Dd, float* OF, bf16_t* YB, const float* b_lb, const float* gout) {
    int tid_ = threadIdx.x; asm volatile("" : "+v"(tid_)); const int tid = tid_, lane = tid & 63, wid = __builtin_amdgcn_readfirstlane(tid >> 6), fr = lane & 15, fq = lane >> 4;
    const int b = task >> 7, h = (task >> 4) & 7, seg = task & 15, row0 = b * S + seg * 1024;
    constexpr int QP = 136;
    bf16_t* QD = (bf16_t*)lds; bf16_t* KI = QD + 64 * QP; bf16_t* KET = KI + 64 * QP; bf16_t* VT = KET + 4 * 128 * 16; float* DEC = (float*)(VT + 4 * 64 * 16); float* OUT = DEC + 512;
    const int pj = tid >> 7, pc = tid & 127;
    const int vn = (tid >> 1) & 63, vsh = tid & 1;
    const int nt = wid & 3;
    for (int dir = 0; dir < 2; ++dir) {
        const float lb = (l == 0) ? 0.f : sigmoidf_(b_lb[(dir * 2 + 1) * 1024 + h * 128 + pc] - b_lb[(dir * 2) * 1024 + h * 128 + pc]);
        f32x4 st[8];
#pragma unroll
        for (int j = 0; j < 8; ++j) st[j] = (f32x4){0.f, 0.f, 0.f, 0.f};
        if (PASS == 3 && wid < 4) {
            for (int q = 0; q < 15; ++q) { const int sp = dir ? 15 - q : q; if (dir ? (sp <= seg) : (sp >= seg)) break;
                const int tk = ((task & ~15) + sp) * 2 + dir; const float* dp = Dd + tk * 128; const float* ep = E + (size_t)tk * 8192 + 16 * nt + fr;
#pragma unroll
                for (int mt = 0; mt < 8; ++mt)
#pragma unroll
                    for (int i = 0; i < 4; ++i) { const int k = 16 * mt + 4 * fq + i; st[mt][i] = dp[k] * st[mt][i] + ep[k * 64]; } }
        }
        float dprod = 1.f;
        const bf16_t* zb = BZ + (dir ? 2048 : 1024) + h * 128 + pc; const bf16_t* qb = BZ + h * 128 + pc; const bf16_t* vb = BZ + 3072 + h * 64 + vn;
        unsigned short zr[16], qr[16], vv[8];
#define HROW(g_) (dir ? row0 + 1023 - (g_) : row0 + (g_))
#define HLOADS(g0_) do { _Pragma("unroll") for (int tp = 0; tp < 16; ++tp) { const size_t rb = (size_t)HROW((g0_) + pj * 16 + tp) * 4096; zr[tp] = zb[rb]; if (PASS == 3) qr[tp] = qb[rb]; } \
            _Pragma("unroll") for (int s8 = 0; s8 < 8; ++s8) vv[s8] = vb[(size_t)HROW((g0_) + pj * 16 + vsh * 8 + s8) * 4096]; } while (0)
        HLOADS(0);
        for (int stg = 0; stg < 16; ++stg) {
            const int g0 = stg * 64;
            {
                float P = 1.f; float ki[16], pv[16];
#pragma unroll
                for (int tp = 0; tp < 16; ++tp) { const float z = bf2f(zr[tp]);
                    const float sp = __builtin_amdgcn_rcpf(1.f + __expf(-z)), sn = __builtin_amdgcn_rcpf(1.f + __expf(z)); const float f = lb + (1.f - lb) * sp, key = (1.f - lb) * sn;
                    P *= f; const float kiv = key * __builtin_amdgcn_rcpf(fmaxf(P, 1e-36f)); ki[tp] = kiv;
                    pv[tp] = P; }
                if (PASS == 3) {
#pragma unroll
                    for (int tp = 0; tp < 16; ++tp) { const float qd_ = bf2f(qr[tp]) * pv[tp]; QD[(pj * 16 + tp) * QP + pc] = (bf16_t)(pk2b(qd_, 0.f) & 0xffffu); KI[(pj * 16 + tp) * QP + pc] = (bf16_t)(pk2b(ki[tp], 0.f) & 0xffffu); } }
                u32x4 w0, w1;
                w0.x = pk2(ki[0] * P, ki[1] * P); w0.y = pk2(ki[2] * P, ki[3] * P); w0.z = pk2(ki[4] * P, ki[5] * P); w0.w = pk2(ki[6] * P, ki[7] * P);
                w1.x = pk2(ki[8] * P, ki[9] * P); w1.y = pk2(ki[10] * P, ki[11] * P); w1.z = pk2(ki[12] * P, ki[13] * P); w1.w = pk2(ki[14] * P, ki[15] * P);
                *(u32x4*)(KET + (pj * 128 + pc) * 16) = w0; *(u32x4*)(KET + (pj * 128 + pc) * 16 + 8) = w1;
                DEC[pj * 128 + pc] = P; if (PASS == 1) dprod *= P;
                u32x4 vw; vw.x = vv[0] | ((unsigned)vv[1] << 16); vw.y = vv[2] | ((unsigned)vv[3] << 16); vw.z = vv[4] | ((unsigned)vv[5] << 16); vw.w = vv[6] | ((unsigned)vv[7] << 16);
                *(u32x4*)(VT + (pj * 64 + vn) * 16 + vsh * 8) = vw;
            }
            __syncthreads();
            if (stg + 1 < 16) HLOADS(g0 + 64);
            if (wid < 4) {
#pragma unroll 1
                for (int j = 0; j < 4; ++j) {
                    const bf16_t* QDj = QD + j * 16 * QP; const bf16_t* KIj = KI + j * 16 * QP; const bf16_t* KETj = KET + j * 128 * 16; const bf16_t* VTj = VT + j * 64 * 16; const float* DECj = DEC + j * 128;
                    const s16x4 vf = *(const s16x4*)(VTj + (16 * nt + fr) * 16 + 4 * fq);
                    if (PASS == 3) {
                        bf16x8 qd[4]; f32x4 sc = {0.f, 0.f, 0.f, 0.f};
#pragma unroll
                        for (int kk = 0; kk < 4; ++kk) { const s16x4 a0 = *(const s16x4*)(QDj + fr * QP + 32 * kk + 4 * fq), a1 = *(const s16x4*)(QDj + fr * QP + 32 * kk + 16 + 4 * fq);
                            qd[kk] = (bf16x8){a0[0], a0[1], a0[2], a0[3], a1[0], a1[1], a1[2], a1[3]};
                            const s16x4 b0 = *(const s16x4*)(KIj + fr * QP + 32 * kk + 4 * fq), b1 = *(const s16x4*)(KIj + fr * QP + 32 * kk + 16 + 4 * fq);
                            const bf16x8 kf = {b0[0], b0[1], b0[2], b0[3], b1[0], b1[1], b1[2], b1[3]};
                            sc = __builtin_amdgcn_mfma_f32_16x16x32_bf16(kf, qd[kk], sc, 0, 0, 0); asm volatile("" :: "v"(kf), "v"(qd[kk])); }
#pragma unroll
                        for (int i = 0; i < 4; ++i) if (4 * fq + i > fr) sc[i] = 0.f;
                        u32x2 sw; sw.x = pk2b(sc[0], sc[1]); sw.y = pk2b(sc[2], sc[3]);
                        const s16x4 swv = __builtin_bit_cast(s16x4, sw);
                        f32x4 z4 = {0.f, 0.f, 0.f, 0.f}; asm volatile("" : "+v"(z4));
                        const bf16x8 sw8 = {swv[0], swv[1], swv[2], swv[3], 0, 0, 0, 0}; const bf16x8 vf8 = {vf[0], vf[1], vf[2], vf[3], 0, 0, 0, 0};
                        f32x4 oacc = __builtin_amdgcn_mfma_f32_16x16x32_bf16(sw8, vf8, z4, 0, 0, 0); asm volatile("" :: "v"(swv), "v"(vf));
#pragma unroll
                        for (int kk = 0; kk < 4; ++kk) { u32x4 sb; sb.x = pk2b(st[2 * kk][0], st[2 * kk][1]); sb.y = pk2b(st[2 * kk][2], st[2 * kk][3]); sb.z = pk2b(st[2 * kk + 1][0], st[2 * kk + 1][1]); sb.w = pk2b(st[2 * kk + 1][2], st[2 * kk + 1][3]);
                            const bf16x8 sbv = __builtin_bit_cast(bf16x8, sb); oacc = __builtin_amdgcn_mfma_f32_16x16x32_bf16(qd[kk], sbv, oacc, 0, 0, 0); asm volatile("" :: "v"(qd[kk]), "v"(sbv)); }
                        asm volatile("s_nop 15\n\ts_nop 15\n\ts_nop 15" : "+v"(oacc));
#pragma unroll
                        for (int i = 0; i < 4; ++i) ((volatile float*)OUT)[(j * 16 + 4 * fq + i) * 64 + 16 * nt + fr] = oacc[i];
                    }
#pragma unroll
                    for (int mt = 0; mt < 8; ++mt) { const f32x4 d = *(const f32x4*)(DECj + 16 * mt + 4 * fq); const s16x4 kef = *(const s16x4*)(KETj + (16 * mt + fr) * 16 + 4 * fq);
                        const bf16x8 ke8 = {kef[0], kef[1], kef[2], kef[3], 0, 0, 0, 0}; const bf16x8 vu8 = {vf[0], vf[1], vf[2], vf[3], 0, 0, 0, 0};
                        st[mt] = __builtin_amdgcn_mfma_f32_16x16x32_bf16(ke8, vu8, st[mt] * d, 0, 0, 0); }
                }
            }
            __syncthreads();
            if (PASS == 3) {
                const int ps = dir ? 63 - (tid >> 3) : (tid >> 3), n8 = (tid & 7) * 8, row = HROW(g0 + ps);
                f32x4 o0 = *(const f32x4*)(OUT + ps * 64 + n8), o1 = *(const f32x4*)(OUT + ps * 64 + n8 + 4);
                float* ofp = OF + (size_t)row * 512 + h * 64 + n8;
                if (dir == 0) { *(f32x4*)ofp = o0; *(f32x4*)(ofp + 4) = o1; }
                else { o0 += *(const f32x4*)ofp; o1 += *(const f32x4*)(ofp + 4);
                    float sq = ((o0[0] * o0[0] + o0[1] * o0[1]) + (o0[2] * o0[2] + o0[3] * o0[3])) + ((o1[0] * o1[0] + o1[1] * o1[1]) + (o1[2] * o1[2] + o1[3] * o1[3]));
                    sq += __shfl_xor(sq, 1); sq += __shfl_xor(sq, 2); sq += __shfl_xor(sq, 4);
                    const float rn = rsqrtf(sq * (1.f / 64.f) + EPS); const u32x4 gw = *(const u32x4*)(BZ + (size_t)row * 4096 + 3584 + h * 64 + n8);
                    const f32x4 g0v = {__uint_as_float(gw.x << 16), __uint_as_float(gw.x & 0xffff0000u), __uint_as_float(gw.y << 16), __uint_as_float(gw.y & 0xffff0000u)};
                    const f32x4 g1v = {__uint_as_float(gw.z << 16), __uint_as_float(gw.z & 0xffff0000u), __uint_as_float(gw.w << 16), __uint_as_float(gw.w & 0xffff0000u)};
                    const f32x4 go0 = *(const f32x4*)(gout + l * 64 + n8), go1 = *(const f32x4*)(gout + l * 64 + n8 + 4); f32x4 y0, y1;
#pragma unroll
                    for (int j = 0; j < 4; ++j) { y0[j] = o0[j] * rn * go0[j] * (g0v[j] * sigmoidf_(g0v[j])); y1[j] = o1[j] * rn * go1[j] * (g1v[j] * sigmoidf_(g1v[j])); }
                    u32x4 yw; yw.x = pk2(y0[0], y0[1]); yw.y = pk2(y0[2], y0[3]); yw.z = pk2(y1[0], y1[1]); yw.w = pk2(y1[2], y1[3]);
                    *(u32x4*)(YB + (size_t)row * 512 + h * 64 + n8) = yw; }
            }
        }
#undef HLOADS
#undef HROW
        if (PASS == 1) { const int tk = task * 2 + dir;
            if (wid < 4) { float* ep = E + (size_t)tk * 8192 + 16 * nt + fr;
#pragma unroll
                for (int mt = 0; mt < 8; ++mt)
#pragma unroll
                    for (int i = 0; i < 4; ++i) ep[(16 * mt + 4 * fq + i) * 64] = st[mt][i]; }
            DEC[tid] = dprod; __syncthreads();
            if (pj == 0) Dd[tk * 128 + pc] = (DEC[pc] * DEC[128 + pc]) * (DEC[256 + pc] * DEC[384 + pc]); }
        __syncthreads();
    }
}

DEV void hgrn_pass3_valu(unsigned char* lds, int task, int l, const bf16_t* BZ, const float* E, const float* Dd, float* OF, bf16_t* YB, const float* b_lb, const float* gout) {
    int tid_ = threadIdx.x; asm volatile("" : "+v"(tid_)); const int tid = tid_, lane = tid & 63, kq = __builtin_amdgcn_readfirstlane(tid >> 6), np = lane & 31, k0 = 16 * kq + 8 * (lane >> 5);
    const int b = task >> 7, h = (task >> 4) & 7, seg = task & 15, row0 = b * S + seg * 1024;
    float* F = (float*)lds; float* QQ = F + 4096; float* V = QQ + 4096; float* PO = V + 2048;
    const int pt = tid >> 4, pk8 = (tid & 15) * 8, pn4 = (tid & 15) * 4;
    float lb[8]; f32x2 S2[2][4];
    u32x4 zw, qw; u32x2 vw;
#define H3_TB(it_) (row0 + ((((it_) >> 5) ? 31 - ((it_) & 31) : ((it_) & 31)) * 32))
#define H3_LOAD(it_, Z_, Q_, V_) do { const size_t rb_ = (size_t)(H3_TB(it_) + pt) * 4096; Z_ = *(const u32x4*)(BZ + rb_ + (((it_) >> 5) ? 2048 : 1024) + h * 128 + pk8); \
        Q_ = *(const u32x4*)(BZ + rb_ + h * 128 + pk8); V_ = *(const u32x2*)(BZ + rb_ + 3072 + h * 64 + pn4); } while (0)
    H3_LOAD(0, zw, qw, vw);
    for (int it = 0; it < 64; ++it) {
        const int dir = it >> 5, stg = it & 31, tb = H3_TB(it);
        if (stg == 0) {
#pragma unroll
            for (int j = 0; j < 8; ++j) { const int c = h * 128 + pk8 + j; lb[j] = (l == 0) ? 0.f : sigmoidf_(b_lb[(dir * 2 + 1) * 1024 + c] - b_lb[(dir * 2) * 1024 + c]); }
#pragma unroll
            for (int j = 0; j < 4; ++j) { S2[0][j] = (f32x2){0.f, 0.f}; S2[1][j] = (f32x2){0.f, 0.f}; }
            for (int q = 0; q < 15; ++q) { const int sp = dir ? 15 - q : q; if (dir ? (sp <= seg) : (sp >= seg)) break;
                const int tk = ((task & ~15) + sp) * 2 + dir; const float* dp = Dd + tk * 128 + k0; const float* ep = E + ((size_t)tk * 128 + k0) * 64 + np;
#pragma unroll
                for (int j = 0; j < 4; ++j)
#pragma unroll
                    for (int nn = 0; nn < 2; ++nn) { S2[nn][j].x = dp[2 * j] * S2[nn][j].x + ep[(2 * j) * 64 + 32 * nn]; S2[nn][j].y = dp[2 * j + 1] * S2[nn][j].y + ep[(2 * j + 1) * 64 + 32 * nn]; } }
        }
        {
            float fo[8];
#pragma unroll
            for (int j = 0; j < 8; ++j) { const unsigned w = zw[j >> 1]; const float z = (j & 1) ? __uint_as_float(w & 0xffff0000u) : __uint_as_float(w << 16);
                const float sp = __builtin_amdgcn_rcpf(1.f + __expf(-z)); fo[j] = lb[j] + (1.f - lb[j]) * sp; }
            *(f32x4*)(F + pt * 128 + pk8) = (f32x4){fo[0], fo[1], fo[2], fo[3]}; *(f32x4*)(F + pt * 128 + pk8 + 4) = (f32x4){fo[4], fo[5], fo[6], fo[7]};
            *(f32x4*)(QQ + pt * 128 + pk8) = (f32x4){__uint_as_float(qw.x << 16), __uint_as_float(qw.x & 0xffff0000u), __uint_as_float(qw.y << 16), __uint_as_float(qw.y & 0xffff0000u)};
            *(f32x4*)(QQ + pt * 128 + pk8 + 4) = (f32x4){__uint_as_float(qw.z << 16), __uint_as_float(qw.z & 0xffff0000u), __uint_as_float(qw.w << 16), __uint_as_float(qw.w & 0xffff0000u)};
            *(f32x4*)(V + pt * 64 + pn4) = (f32x4){__uint_as_float(vw.x << 16), __uint_as_float(vw.x & 0xffff0000u), __uint_as_float(vw.y << 16), __uint_as_float(vw.y & 0xffff0000u)};
        }
        __syncthreads();
        if (it + 1 < 64) H3_LOAD(it + 1, zw, qw, vw);
        const int crow = tb + pt; float* ofp = OF + (size_t)crow * 512 + h * 64 + pn4;
        f32x4 ofv = {0.f, 0.f, 0.f, 0.f}; u32x2 gw = {0u, 0u};
        if (dir == 1) { ofv = *(const f32x4*)ofp; gw = *(const u32x2*)(BZ + (size_t)crow * 4096 + 3584 + h * 64 + pn4); }
#define H3_LD(i_, FA_, FB_, QA_, QB_, V0_, V1_) do { const int t_ = dir ? 31 - (i_) : (i_); const f32x4* Fp_ = (const f32x4*)(F + t_ * 128 + k0); const f32x4* Qp_ = (const f32x4*)(QQ + t_ * 128 + k0); \
            FA_ = Fp_[0]; FB_ = Fp_[1]; QA_ = Qp_[0]; QB_ = Qp_[1]; V0_ = V[t_ * 64 + np]; V1_ = V[t_ * 64 + np + 32]; } while (0)
#define H3_HALF(j_, F4_, Q4_) do { const f32x2 fa = {F4_[0], F4_[1]}, fb = {F4_[2], F4_[3]}, ka = 1.f - fa, kb = 1.f - fb, qa = {Q4_[0], Q4_[1]}, qb = {Q4_[2], Q4_[3]}; \
            S2[0][2 * (j_)] = fa * S2[0][2 * (j_)] + ka * vv0; S2[0][2 * (j_) + 1] = fb * S2[0][2 * (j_) + 1] + kb * vv0; S2[1][2 * (j_)] = fa * S2[1][2 * (j_)] + ka * vv1; S2[1][2 * (j_) + 1] = fb * S2[1][2 * (j_) + 1] + kb * vv1; \
            po0 += qa * S2[0][2 * (j_)]; po0 += qb * S2[0][2 * (j_) + 1]; po1 += qa * S2[1][2 * (j_)]; po1 += qb * S2[1][2 * (j_) + 1]; } while (0)
#define H3_STEP(i_, FA_, FB_, QA_, QB_, V0_, V1_) do { const int t = dir ? 31 - (i_) : (i_); const f32x2 vv0 = {V0_, V0_}, vv1 = {V1_, V1_}; f32x2 po0 = {0.f, 0.f}, po1 = {0.f, 0.f}; \
            H3_HALF(0, FA_, QA_); H3_HALF(1, FB_, QB_); const float t0 = hsum32(po0.x + po0.y), t1 = hsum32(po1.x + po1.y); PO[(t * 8 + kq) * 64 + lane] = (lane < 32) ? t0 : t1; } while (0)
        {
            f32x4 fa0, fb0, qa0, qb0, fa1, fb1, qa1, qb1; float va0, vb0, va1, vb1;
            H3_LD(0, fa0, fb0, qa0, qb0, va0, vb0);
#pragma unroll 1
            for (int i = 0; i < 32; i += 2) {
                H3_LD(i + 1, fa1, fb1, qa1, qb1, va1, vb1);
                H3_STEP(i, fa0, fb0, qa0, qb0, va0, vb0);
                if (i + 2 < 32) H3_LD(i + 2, fa0, fb0, qa0, qb0, va0, vb0);
                H3_STEP(i + 1, fa1, fb1, qa1, qb1, va1, vb1);
            }
        }
#undef H3_LD
#undef H3_HALF
#undef H3_STEP
        __syncthreads();
        {
            f32x4 o = {0.f, 0.f, 0.f, 0.f};
#pragma unroll
            for (int q = 0; q < 8; ++q) o += *(const f32x4*)(PO + (pt * 8 + q) * 64 + pn4);
            if (dir == 0) *(f32x4*)ofp = o;
            else { o += ofv; float sq = (o[0] * o[0] + o[1] * o[1]) + (o[2] * o[2] + o[3] * o[3]);
                sq += __shfl_xor(sq, 1); sq += __shfl_xor(sq, 2); sq += __shfl_xor(sq, 4); sq += __shfl_xor(sq, 8);
                const float rn = rsqrtf(sq * (1.f / 64.f) + EPS);
                const f32x4 g = {__uint_as_float(gw.x << 16), __uint_as_float(gw.x & 0xffff0000u), __uint_as_float(gw.y << 16), __uint_as_float(gw.y & 0xffff0000u)};
                const f32x4 go = *(const f32x4*)(gout + l * 64 + pn4); f32x4 y;
#pragma unroll
                for (int j = 0; j < 4; ++j) y[j] = o[j] * rn * go[j] * (g[j] * sigmoidf_(g[j]));
                st4(YB + (size_t)crow * 512 + h * 64 + pn4, y); }
        }
    }
    __syncthreads();
#undef H3_TB
#undef H3_LOAD
}

DEV int prep_map(int kind, int r, int p0, int& sel) {
    sel = 0;
    switch (kind) {
    case 0: return p0 + r;
    case 1: if (r < 384) return r; if (r < 512) return 5280 + (r - 384); if (r < 768) return 384 + (r - 512); if (r < 1280) return 4768 + (r - 768); if (r < 1312) return 640 + (r - 1280); return -1;
    case 2: return r < 128 ? 5408 + r : -1;
    case 3: { const int pn = r >> 8, c = r & 255, s = 2 * (c >> 7) + ((c >> 4) & 1), mc = 16 * ((c >> 5) & 3) + (c & 15); return s < 3 ? 5536 + 1024 * s + 64 * pn + mc : -1; }
    case 4: return (r >> 6) * 128 + (r & 63);
    case 5: return (r >> 6) * 128 + 64 + (r & 63);
    default: { const int pn = r >> 8, c = r & 255; sel = c >> 7; return 128 * pn + (c & 127); }
    }
}
DEV void prep_item(const float* Wa, const float* Wb, const float* gain, int K, int Nsrc, bf16_t* dst, int rows, int kind, int p0, float* scr, int item, int lane) {
    const int nblk = rows / 32, kb = item / nblk, nb = item % nblk, k0 = 64 * kb, r0 = 32 * nb;
    int sel; const int col = prep_map(kind, r0 + (lane & 31), p0, sel); const float* W = sel ? Wb : Wa;
#pragma unroll 8
    for (int i = 0; i < 32; ++i) { const int kk = 2 * i + (lane >> 5); float v = (col >= 0) ? W[(size_t)(k0 + kk) * Nsrc + col] : 0.f; if (gain) v *= gain[k0 + kk]; scr[kk * 33 + (lane & 31)] = v; }
    asm volatile("s_waitcnt lgkmcnt(0)" ::: "memory");
    const int c = lane & 7;
#pragma unroll
    for (int j = 0; j < 4; ++j) { const int nn = (lane >> 3) + 8 * j; const float* s = scr + (8 * c) * 33 + nn;
        u32x4 o; o.x = pk2(s[0 * 33], s[1 * 33]); o.y = pk2(s[2 * 33], s[3 * 33]); o.z = pk2(s[4 * 33], s[5 * 33]); o.w = pk2(s[6 * 33], s[7 * 33]);
        *(u32x4*)(dst + (size_t)(r0 + nn) * K + k0 + 8 * c) = o; }
    asm volatile("s_waitcnt lgkmcnt(0)" ::: "memory");
}
struct Params { const float* in[26]; float* out; unsigned char* ws; int stop; int pad; };
struct Job { const float* Wa; const float* Wb; const float* gain; int K, Nsrc, rows, kind, p0; size_t off; };
DEV Job get_job(const Params& p, int j, int l) {
    Job J; J.Wb = nullptr; J.gain = nullptr; J.kind = 0; J.p0 = 0;
    const float* win = p.in[2] + (size_t)l * 1024 * 8608; const float* gmix = p.in[3] + l * 1024;
    switch (j) {
    case 0: J.Wa = win; J.gain = gmix; J.K = 1024; J.Nsrc = 8608; J.rows = 4096; J.p0 = 672; J.off = W_1B; break;
    case 1: J.Wa = win; J.gain = gmix; J.K = 1024; J.Nsrc = 8608; J.rows = 1536; J.kind = 1; J.off = W_1AC; break;
    case 2: J.Wa = win; J.gain = gmix; J.K = 1024; J.Nsrc = 8608; J.rows = 256; J.kind = 2; J.off = W_1CVT; break;
    case 3: J.Wa = win; J.gain = gmix; J.K = 1024; J.Nsrc = 8608; J.rows = 4096; J.kind = 3; J.off = W_G; break;
    case 4: J.Wa = p.in[6] + (size_t)l * 384 * 768; J.gain = p.in[4] + l * 384; J.K = 384; J.Nsrc = 768; J.rows = 768; J.off = W_UQ; break;
    case 5: J.Wa = p.in[7] + (size_t)l * 256 * 1024; J.gain = p.in[5] + l * 256; J.K = 256; J.Nsrc = 1024; J.rows = 512; J.kind = 4; J.off = W_UK; break;
    case 6: J.Wa = p.in[7] + (size_t)l * 256 * 1024; J.gain = p.in[5] + l * 256; J.K = 256; J.Nsrc = 1024; J.rows = 512; J.kind = 5; J.off = W_UV; break;
    case 7: J.Wa = p.in[12] + (size_t)l * 512 * 1024; J.K = 512; J.Nsrc = 1024; J.rows = 1024; J.off = W_BR; break;
    case 8: J.Wa = p.in[13] + (size_t)l * 512 * 1024; J.K = 512; J.Nsrc = 1024; J.rows = 1024; J.off = W_BR + MiB; break;
    case 9: J.Wa = p.in[14] + (size_t)l * 512 * 1024; J.K = 512; J.Nsrc = 1024; J.rows = 1024; J.off = W_BR + 2 * MiB; break;
    case 10: J.Wa = p.in[15] + (size_t)l * 1024 * 1024; J.K = 1024; J.Nsrc = 1024; J.rows = 1024; J.off = W_OUT; break;
    case 11: J.Wa = p.in[18] + (size_t)l * 1024 * 1024; J.gain = p.in[16] + l * 1024; J.K = 1024; J.Nsrc = 1024; J.rows = 1024; J.off = W_XQ; break;
    case 12: J.Wa = p.in[19] + (size_t)l * 1024 * 2048; J.K = 1024; J.Nsrc = 2048; J.rows = 1024; J.off = W_XK; break;
    case 13: J.Wa = p.in[19] + (size_t)l * 1024 * 2048; J.K = 1024; J.Nsrc = 2048; J.rows = 1024; J.p0 = 1024; J.off = W_XV; break;
    case 14: J.Wa = p.in[20] + (size_t)l * 1024 * 1024; J.K = 1024; J.Nsrc = 1024; J.rows = 1024; J.off = W_XO; break;
    case 15: J.Wa = p.in[22] + (size_t)l * 1024 * FF; J.Wb = p.in[23] + (size_t)l * 1024 * FF; J.gain = p.in[21] + l * 1024; J.K = 1024; J.Nsrc = FF; J.rows = 5632; J.kind = 6; J.off = W_13; break;
    default: J.Wa = p.in[24] + (size_t)l * FF * 1024; J.K = FF; J.Nsrc = 1024; J.rows = 1024; J.off = W_2; break;
    }
    return J;
}
DEV void prep_weights(const Params& p, int l, unsigned char* lds, int gw, int NGW, int wid, int lane) {
    float* scr = (float*)lds + wid * (64 * 33);
    int base = 0;
    for (int j = 0; j < 17; ++j) {
        const Job J = get_job(p, j, l); const int cnt = (J.K / 64) * (J.rows / 32);
        int first = gw - (base % NGW); if (first < 0) first += NGW;
        for (int r = first; r < cnt; r += NGW) prep_item(J.Wa, J.Wb, J.gain, J.K, J.Nsrc, (bf16_t*)(p.ws + WS_W + J.off), J.rows, J.kind, J.p0, scr, r, lane);
        base += cnt;
    }
}
#ifndef PHMASK
#define PHMASK 0xFFFFFFFFu
#endif
#define ON(k) (((PHMASK) >> (k)) & 1u)
#ifndef REPMASK
#define REPMASK 0u
#endif
#define REPS(k) ((((REPMASK) >> (k)) & 1u) ? 2 : 1)
DEV const Params* kparams() { const Params* q = (const Params*)__builtin_amdgcn_kernarg_segment_ptr(); asm volatile("" : "+s"(q)); return q; }
#define WPTR(off_) ((const bf16_t*)(w + WS_W + (off_)))
#define R2P(off_) ((bf16_t*)(w + WS_R2 + (off_)))
__global__ void __launch_bounds__(512, 2) mega(Params p_unused) {
    extern __shared__ __attribute__((aligned(16))) unsigned char lds[];
    cg::grid_group grid = cg::this_grid();
    {
        volatile PG8_LAS unsigned* st0 = (volatile PG8_LAS unsigned*)((PG8_LAS unsigned char*)lds + LDS_BYTES - 64);
        if (threadIdx.x == 0) { st0[0] = 0u; st0[1] = 0u; }
        __syncthreads();
        (void)xcd_barrier_post((unsigned*)(launder(kparams()->ws) + WS_MISC + M_BAR), st0);
    }
#define SEAM() do { XcdBarrier b_; b_.bar = (unsigned*)(launder(kparams()->ws) + WS_MISC + M_BAR); b_.x = xb_xcc_id(); b_.st = (volatile PG8_LAS unsigned*)((PG8_LAS unsigned char*)lds + LDS_BYTES - 64); xcd_barrier(b_); } while (0)
#define TIDS int tid_ = threadIdx.x; asm volatile("" : "+v"(tid_)); const int tid = tid_, lane = tid & 63, wid = __builtin_amdgcn_readfirstlane(tid >> 6); (void)tid; (void)lane; (void)wid;
    if (ON(0)) for (int rep_ = 0; rep_ < REPS(0); ++rep_) {
        TIDS const Params& p = *kparams(); unsigned char* w = launder(p.ws);
        const int G = gridDim.x, bx = blockIdx.x, gw = bx * 8 + wid, NGW = G * 8;
        bf16_t* XB = (bf16_t*)(w + WS_XB); u64_t* SS = SSP(w, 0);
        float* RC = (float*)(w + WS_MISC + M_ROPE); float* RS = RC + S * 16; float* BT = (float*)(w + WS_MISC + M_BT); bf16_t* MEMN = (bf16_t*)(w + WS_MISC + M_MEMN);
        const float* x = p.in[0];
        for (int row = gw; row < T; row += NGW) {
            const f32x4* xr = (const f32x4*)(x + (size_t)row * D) + lane; float ss = 0.f;
#pragma unroll
            for (int j = 0; j < 4; ++j) { const f32x4 v = xr[64 * j]; ss += (v[0] * v[0] + v[1] * v[1]) + (v[2] * v[2] + v[3] * v[3]);
                st4(XB + (size_t)row * D + (lane + 64 * j) * 4, v); }
            ss = wave_sum(ss); if (lane == 0) SS[row] = ss_fix(ss);
        }
        for (size_t i = (size_t)bx * 512 + tid; i < (size_t)10 * T; i += (size_t)G * 512) SS[T + i] = 0ull;
        for (int r = gw; r < 1024; r += NGW) {
            const int l = r >> 9, row = r & 511; const f32x4* xr = (const f32x4*)(p.in[1] + (size_t)row * D) + lane; f32x4 v[4]; float ss = 0.f;
#pragma unroll
            for (int j = 0; j < 4; ++j) { v[j] = xr[64 * j]; ss += (v[j][0] * v[j][0] + v[j][1] * v[j][1]) + (v[j][2] * v[j][2] + v[j][3] * v[j][3]); }
            const float rs = rsqrtf(wave_sum(ss) * (1.f / 1024.f) + EPS);
#pragma unroll
            for (int j = 0; j < 4; ++j) { const f32x4 g = *((const f32x4*)(p.in[17] + l * D) + lane + 64 * j); st4(MEMN + (size_t)r * D + (lane + 64 * j) * 4, v[j] * rs * g); }
        }
        for (int i = bx * 512 + tid; i < S * 16; i += G * 512) {
            const int pos = i >> 4, j = i & 15; const float inv = powf(10000.f, -(float)j / 16.f); const float ang = (float)pos * inv;
            const double a = (double)ang; const double k = rint(a * 0.15915494309189535); const float rr = (float)(a - k * 6.283185307179586);
            RC[i] = cosf(rr); RS[i] = sinf(rr);
        }
        for (int i = bx * 512 + tid; i < 8 * 260; i += G * 512) {
            const int h = i / 260, idx = i % 260; float val = 0.f;
            if (idx <= 256) { const int rel = idx - 128, n = rel < 0 ? -rel : rel; int bk = rel > 0 ? 16 : 0;
                if (n < 8) bk += n; else { int lg = 8 + (int)(logf((float)n / 8.f) / 2.772588722239781f * 8.f + 1e-4f); bk += lg < 15 ? lg : 15; }
                val = p.in[11][bk * 8 + h] * LOG2E; }
            BT[i] = val;
        }
        prep_weights(p, 0, lds, gw, NGW, wid, lane);
    }
    grid.sync();
#pragma unroll 1
    for (int l = 0; l < 2; ++l) {
        if (l == 1) { if (ON(0)) for (int rep_ = 0; rep_ < REPS(0); ++rep_) { TIDS const Params& p = *kparams(); prep_weights(p, 1, lds, blockIdx.x * 8 + wid, gridDim.x * 8, wid, lane); } SEAM(); }
        if (ON(1)) for (int rep_ = 0; rep_ < REPS(1); ++rep_) {
            unsigned char* w = launder(kparams()->ws); const bf16_t* memn = (const bf16_t*)(w + WS_MISC + M_MEMN) + (size_t)l * 512 * D;
            run_gemm(lds, (const bf16_t*)(w + WS_XB), D, WPTR(W_1B), D, T, 4096, D, EpiRowP{w, WS_R2 + R_BZ, 4096, l * 5, 1.f / 1024.f, 1.f});
            run_gemm(lds, memn, D, WPTR(W_XK), D, 512, 1024, D, EpiRowP{w, WS_MISC + M_KX, 1024, -1, 0.f, 1.f});
            run_gemm(lds, WPTR(W_XV), D, memn, D, 1024, 512, D, EpiCol{w, WS_MISC + M_VXT, 512, -1, 0.f, 1024});
        }
        SEAM();
        if (ON(2)) for (int rep_ = 0; rep_ < REPS(2); ++rep_) {
            const Params& p = *kparams(); unsigned char* w = launder(p.ws);
            for (int task = blockIdx.x; task < 256; task += gridDim.x) hgrn_task<1>(lds, task, l, R2P(R_BZ), (float*)(w + WS_ST), (float*)(w + WS_MISC + M_HD), (float*)(w + WS_YA), (bf16_t*)(w + WS_YB), p.in[8], p.in[9]);
        }
        SEAM();
        if (ON(3)) {
            const Params& p = *kparams(); unsigned char* w = launder(p.ws);
            for (int task = blockIdx.x; task < 256; task += gridDim.x) hgrn_task<3>(lds, task, l, R2P(R_BZ), (float*)(w + WS_ST), (float*)(w + WS_MISC + M_HD), (float*)(w + WS_YA), (bf16_t*)(w + WS_YB), p.in[8], p.in[9]);
        }
        SEAM();
        if (ON(5)) for (int rep_ = 0; rep_ < REPS(5); ++rep_) {
            unsigned char* w = launder(kparams()->ws);
            run_gemm(lds, (const bf16_t*)(w + WS_XB), D, WPTR(W_1AC), D, T, 1536, D, EpiAC{w, l});
            run_gemm(lds, WPTR(W_1CVT), D, (const bf16_t*)(w + WS_XB), D, 256, T, D, EpiCol{w, WS_R2 + R_CVT, T, l * 5, 1.f / 1024.f, 128});
        }
        SEAM();
        if (ON(6)) for (int rep_ = 0; rep_ < REPS(6); ++rep_) {
            unsigned char* w = launder(kparams()->ws);
            run_gemm(lds, R2P(R_ACQ), 384, WPTR(W_UQ), 384, T, 768, 384, EpiQ{w, l});
            run_gemm(lds, R2P(R_ACKV), 256, WPTR(W_UK), 256, T, 512, 256, EpiRow<true>{w, WS_R2 + R_KA, 768, l * 5 + 2, 1.f / 256.f, 1.f});
            run_gemm(lds, WPTR(W_UV), 256, R2P(R_ACKV), 256, 512, T, 256, EpiCol{w, WS_R2 + R_VAT, T, l * 5 + 2, 1.f / 256.f, 512});
        }
        SEAM();
        if (ON(7)) for (int rep_ = 0; rep_ < REPS(7); ++rep_) {
            const Params& p = *kparams(); unsigned char* w = launder(p.ws);
            const int G = gridDim.x, bx = blockIdx.x, vcu = (G % 8 == 0) ? (bx % 8) * (G / 8) + bx / 8 : bx;
            bf16_t* QA = R2P(R_QA); bf16_t* KA = R2P(R_KA); bf16_t* VAT = R2P(R_VAT); bf16_t* YA = (bf16_t*)(w + WS_YA);
            for (int i = 0; i < (512 + G - 1) / G; ++i) {
                const int u = (G == 256) ? (vcu >> 5) * 64 + i * 32 + (vcu & 31) : i * G + bx; if (u >= 512) break;
                const int bh = u >> 5, qb = u & 31, b = bh >> 3, h = bh & 7; const size_t row0 = (size_t)b * S + qb * 512;
                mla_unit((PG8_LAS unsigned char*)lds, QA + row0 * 768 + h * 96, KA + (size_t)b * S * 768 + h * 96, VAT + (size_t)(h * 64) * T + (size_t)b * S, YA + row0 * 512 + h * 64);
            }
            bf16_t* CQ = R2P(R_CQ); bf16_t* CK = R2P(R_CK); bf16_t* CVT = R2P(R_CVT); bf16_t* YC = (bf16_t*)(w + WS_YC); const float* BT = (const float*)(w + WS_MISC + M_BT);
            for (int u = bx; u < 1024; u += G) {
                const int bh = u >> 6, qb = u & 63, b = bh >> 3, h = bh & 7, kvh = h >> 2; const size_t row0 = (size_t)b * S + qb * 256;
                const int k0 = max(0, qb * 256 - 128), k1 = min(S, qb * 256 + 384);
                attn_unit<64, 64, 1, 1, true>(lds, CQ + row0 * 512 + h * 64, 512, CK + (size_t)b * S * 128 + kvh * 64, 128, CVT + (size_t)(kvh * 64) * T + (size_t)b * S, T, YC + row0 * 512 + h * 64, 512,
                                              k0, (k1 - k0) / 64, qb * 256, BT + h * 260, p.in[10][l * 8 + h] * LOG2E);
            }
        }
        SEAM();
        if (ON(8)) for (int rep_ = 0; rep_ < REPS(8); ++rep_) {
            unsigned char* w = launder(kparams()->ws);
            run_gemm(lds, (const bf16_t*)(w + WS_YA), 512, WPTR(W_BR), 512, T, 1024, 512, EpiRowP{w, WS_R2 + R_PBR, 3072, -1, 0.f, 1.f});
            run_gemm(lds, (const bf16_t*)(w + WS_YB), 512, WPTR(W_BR + MiB), 512, T, 1024, 512, EpiRowP{w, WS_R2 + R_PBR + 2048, 3072, -1, 0.f, 1.f});
            run_gemm(lds, (const bf16_t*)(w + WS_YC), 512, WPTR(W_BR + 2 * MiB), 512, T, 1024, 512, EpiRowP{w, WS_R2 + R_PBR + 4096, 3072, -1, 0.f, 1.f});
        }
        SEAM();
        if (ON(9)) for (int rep_ = 0; rep_ < REPS(9); ++rep_) { unsigned char* w = launder(kparams()->ws); run_gemm(lds, (const bf16_t*)(w + WS_XB), D, WPTR(W_G), D, T, 4096, D, EpiMerge{w, l}); }
        SEAM();
        if (ON(10)) for (int rep_ = 0; rep_ < REPS(10); ++rep_) { const Params& p = *kparams(); unsigned char* w = launder(p.ws); run_gemm(lds, R2P(R_MERGED), D, WPTR(W_OUT), D, T, 1024, D, EpiRes{w, l == 0 ? p.in[0] : (const float*)p.out, p.out, l * 5 + 3}); }
        SEAM();
        if (ON(11)) for (int rep_ = 0; rep_ < REPS(11); ++rep_) { unsigned char* w = launder(kparams()->ws); run_gemm(lds, (const bf16_t*)(w + WS_XB), D, WPTR(W_XQ), D, T, 1024, D, EpiRowP{w, WS_R2 + R_QX, 1024, l * 5 + 3, 1.f / 1024.f, 0.0625f * LOG2E}); }
        SEAM();
        if (ON(12)) for (int rep_ = 0; rep_ < REPS(12); ++rep_) {
            unsigned char* w = launder(kparams()->ws); bf16_t* QX = R2P(R_QX); bf16_t* OX = R2P(R_OX); const bf16_t* KX = (const bf16_t*)(w + WS_MISC + M_KX); const bf16_t* VXT = (const bf16_t*)(w + WS_MISC + M_VXT);
            for (int u = blockIdx.x; u < 1024; u += gridDim.x) {
                const int qb = u >> 2, h = u & 3; const size_t row0 = (size_t)qb * 128; const int b = qb >> 7;
                attn_unit<256, 256, 2, 0, false>(lds, QX + row0 * 1024 + h * 256, 1024, KX + (size_t)b * 256 * 1024 + h * 256, 1024, VXT + (size_t)(h * 256) * 512 + b * 256, 512, OX + row0 * 1024 + h * 256, 1024, 0, 4, 0, nullptr, 0.f);
            }
        }
        SEAM();
        if (ON(13)) for (int rep_ = 0; rep_ < REPS(13); ++rep_) { const Params& p = *kparams(); unsigned char* w = launder(p.ws); run_gemm(lds, R2P(R_OX), D, WPTR(W_XO), D, T, 1024, D, EpiRes{w, p.out, p.out, l * 5 + 4}); }
        SEAM();
        if (ON(14)) for (int rep_ = 0; rep_ < REPS(14); ++rep_) { unsigned char* w = launder(kparams()->ws); run_gemm(lds, (const bf16_t*)(w + WS_XB), D, WPTR(W_13), D, T, 5632, D, EpiFfn{w, l * 5 + 4}); }
        SEAM();
        if (ON(15)) for (int rep_ = 0; rep_ < REPS(15); ++rep_) { const Params& p = *kparams(); unsigned char* w = launder(p.ws); run_gemm(lds, R2P(R_HID), FF, WPTR(W_2), FF, T, 1024, FF, EpiRes{w, p.out, p.out, (l + 1) * 5}); }
        SEAM();
    }
    {
        TIDS const Params& p = *kparams(); unsigned char* w = launder(p.ws); float* X = p.out; const u64_t* ssf = SSP(w, 10);
        for (int row = blockIdx.x * 8 + wid; row < T; row += gridDim.x * 8) {
            const float rs = rstd_of(ssf, row, 1.f / 1024.f); f32x4* xr = (f32x4*)(X + (size_t)row * D) + lane;
#pragma unroll
            for (int j = 0; j < 4; ++j) { const f32x4 g = *((const f32x4*)p.in[25] + lane + 64 * j); xr[64 * j] = xr[64 * j] * rs * g; }
        }
    }
}

extern "C" void kernel_launch(void* const* d_in, const int* in_sizes, int n_in, void* d_out, int out_size, void* d_ws, size_t ws_size, hipStream_t stream) {
    static int grid_blocks = 0;
    if (grid_blocks == 0) {
        if (n_in != 26 || out_size != T * D || ws_size < WS_END) { fprintf(stderr, "kernel_launch: unexpected shapes n_in %d out %d ws %zu\n", n_in, out_size, ws_size); grid_blocks = -1; return; }
        int dev = 0, cus = 0, per_cu = 0;
        (void)hipGetDevice(&dev); (void)hipDeviceGetAttribute(&cus, hipDeviceAttributeMultiprocessorCount, dev);
        (void)hipFuncSetAttribute((const void*)mega, hipFuncAttributeMaxDynamicSharedMemorySize, LDS_BYTES);
        if (hipOccupancyMaxActiveBlocksPerMultiprocessor(&per_cu, (const void*)mega, 512, LDS_BYTES) != hipSuccess || per_cu < 1) per_cu = 1;
        (void)hipGetLastError();
        grid_blocks = cus * 1;
        fprintf(stderr, "kernel_launch: grid %d (cus %d, per_cu %d), ws %zu\n", grid_blocks, cus, per_cu, ws_size);
    }
    if (grid_blocks < 0) return;
    if (hipMemsetAsync((unsigned char*)d_ws + WS_MISC + M_BAR, 0, 16384, stream) != hipSuccess) { fprintf(stderr, "kernel_launch: memset of the barrier words failed\n"); return; }
    Params p{};
    for (int i = 0; i < 26; ++i) p.in[i] = (const float*)d_in[i];
    p.out = (float*)d_out; p.ws = (unsigned char*)d_ws; p.stop = 0; p.pad = 0;
    void* args[] = {&p};
    hipError_t e = hipLaunchCooperativeKernel((void*)mega, dim3(grid_blocks), dim3(512), args, LDS_BYTES, stream);
    if (e != hipSuccess) fprintf(stderr, "cooperative launch failed: %s (grid %d)\n", hipGetErrorString(e), grid_blocks);
}
```

```cpp
#include <hip/hip_runtime.h>
#include <hip/hip_cooperative_groups.h>
#include <cstdio>
#include <cstdint>
namespace cg = cooperative_groups;
#define DEV __device__ __forceinline__
namespace pg8 {
#define PG8_LAS __attribute__((address_space(3)))
typedef unsigned short bf16_t;
typedef short bf16x8 __attribute__((ext_vector_type(8)));
typedef float f32x4 __attribute__((ext_vector_type(4)));
typedef unsigned u32x4 __attribute__((ext_vector_type(4)));
constexpr int BM = 256, BK = 64, HALF = 128, HTB = HALF * BK * 2  , STAGE_BYTES = 8 * HTB, NXCD = 8, WGM = 8;

__host__ __device__ __forceinline__ int lds_byte(int r, int c) { const int st = (r >> 4) * 2 + (c >> 5), rr = r & 15, cc = c & 31, ob = rr * 64 + cc * 2; return st * 1024 + (ob ^ (((ob >> 9) & 1) << 5)); }
__host__ __device__ __forceinline__ void stage_rc(int b, int& R, int& C) { const int st = b / 1024, sb = b % 1024, swz = sb ^ (((sb >> 9) & 1) << 5); R = (st >> 1) * 16 + swz / 64; C = (st & 1) * 32 + (swz % 64) / 2; }
__host__ __device__ __forceinline__ int perm32(int rho) { const int n = rho >> 4, i = rho & 15; return 8 * (i >> 2) + 4 * n + (i & 3); }

struct Unit { int pm, pn; };
struct Gemm { const bf16_t* A; const bf16_t* Bt; int M, N, K, lda, ldb; };

struct StaticOrder {
    int nM, nN, nwg, G, c;
    __host__ __device__ void init(int M, int N, int G_, int c_) { nM = M / BM; nN = N / BM; nwg = nM * nN; G = G_; c = c_; }
    __host__ __device__ bool next(int i, Unit& u) const {
        const long L = (long)i * G + c; if (L >= nwg) return false;
        int wgid = (int)L; { const int q = nwg / NXCD, r = nwg % NXCD, xcd = wgid % NXCD, off = wgid / NXCD; wgid = (xcd < r ? xcd * (q + 1) : r * (q + 1) + (xcd - r) * q) + off; }
        const int nig = WGM * nN, gid = wgid / nig, fm = gid * WGM, gsz = (nM - fm) < WGM ? (nM - fm) : WGM;
        u.pm = fm + ((wgid % nig) % gsz); u.pn = (wgid % nig) / gsz; return true;
    }
    __device__ __forceinline__ void a_ready(const Unit&) const {}
    __device__ __forceinline__ void done(const Unit&) const {}
};

__device__ __forceinline__ unsigned cvt_pk_bf16(float lo, float hi) { unsigned r; asm volatile("v_cvt_pk_bf16_f32 %0, %1, %2" : "=v"(r) : "v"(lo), "v"(hi)); return r; }
typedef float f32x2 __attribute__((ext_vector_type(2)));
template <class Epi, class Sched, bool ALIGN_EPI = false, bool SP2 = false>
__device__ __forceinline__ void gemm_phase(PG8_LAS unsigned char* lds, const Gemm g, const Sched& S, const Epi& E) {
    int tid_ = threadIdx.x; asm volatile("" : "+v"(tid_)); const int tid = tid_, wid = __builtin_amdgcn_readfirstlane(tid >> 6), lane = tid & 63, wr = wid >> 2, wc = wid & 3, fr = lane & 15, fq = lane >> 4;
    const int K = g.K, nt = K / BK;
    unsigned voffA[2], voffB[2];
#pragma unroll
    for (int i = 0; i < 2; ++i) { int R, C; stage_rc(tid * 16 + i * 8192, R, C); const int Rb = Epi::PERM ? ((R & ~31) + perm32(R & 31)) : R;
        voffA[i] = (unsigned)(R * g.lda + C) * 2u; voffB[i] = (unsigned)(Rb * g.ldb + C) * 2u; }
    const size_t kstep = (size_t)(BK * 2);
    const size_t hstepA = (size_t)HALF * g.lda * 2, hstepB = (size_t)HALF * g.ldb * 2;
    const size_t tstepA = 2 * hstepA, tstepB = 2 * hstepB;
    const unsigned ldsw = (unsigned)wid * 1024u;
    const int aoff = lds_byte(wr * 64 + fr, fq * 8), boff = lds_byte(wc * 32 + fr, fq * 8);
#define PG8_SA(b, h) (((b) * 2 + (h)) * HTB)
#define PG8_SB(b, h) ((4 + (b) * 2 + (h)) * HTB)
#define PG8_STAGE(bufoff, gbase, voff) do { _Pragma("unroll") for (int _i = 0; _i < 2; ++_i) \
        __builtin_amdgcn_global_load_lds((const unsigned*)((const char*)(gbase) + (voff)[_i]), (PG8_LAS unsigned*)(lds + (bufoff) + ldsw + _i * 8192), 16, 0, 0); } while (0)
#define PG8_LDA(dst, b, h) do { _Pragma("unroll") for (int m = 0; m < 4; ++m) _Pragma("unroll") for (int k = 0; k < 2; ++k) dst[m][k] = *(const PG8_LAS bf16x8*)(lds + PG8_SA(b, h) + aoff + m * 2048 + k * 1024); } while (0)
#define PG8_LDB(dst, b, h) do { _Pragma("unroll") for (int n = 0; n < 2; ++n) _Pragma("unroll") for (int k = 0; k < 2; ++k) dst[n][k] = *(const PG8_LAS bf16x8*)(lds + PG8_SB(b, h) + boff + n * 2048 + k * 1024); } while (0)
#define PG8_MMA(ai, bj, At, Bt) do { __builtin_amdgcn_s_setprio(1); _Pragma("unroll") for (int m = 0; m < 4; ++m) _Pragma("unroll") for (int n = 0; n < 2; ++n) _Pragma("unroll") for (int k = 0; k < 2; ++k) \
        acc[ai][bj][m][n] = __builtin_amdgcn_mfma_f32_16x16x32_bf16(Bt[n][k], At[m][k], acc[ai][bj][m][n], 0, 0, 0); __builtin_amdgcn_s_setprio(0); } while (0)
#define PG8_WAIT_V(n) asm volatile("s_waitcnt vmcnt(" #n ")" ::: "memory")
#define PG8_WAIT_L(n) asm volatile("s_waitcnt lgkmcnt(" #n ")" ::: "memory")
#define PG8_BAR __builtin_amdgcn_s_barrier()
#define PG8_SCHED __builtin_amdgcn_sched_barrier(0)
    Unit cur, nxt; int ui = 0;
    if (!S.next(0, cur)) return;
    f32x4 acc[2][2][4][2];
#pragma unroll
    for (int a = 0; a < 2; ++a)
#pragma unroll
        for (int b = 0; b < 2; ++b)
#pragma unroll
            for (int m = 0; m < 4; ++m)
#pragma unroll
                for (int n = 0; n < 2; ++n) acc[a][b][m][n] = (f32x4){0.f, 0.f, 0.f, 0.f};
    bf16x8 At[4][2], B0[2][2], B1[2][2];
    const char* cA = (const char*)g.A + (size_t)cur.pm * tstepA; const char* cB = (const char*)g.Bt + (size_t)cur.pn * tstepB;
    S.a_ready(cur);
    if constexpr (SP2) {
        PG8_STAGE(PG8_SB(0, 0), cB, voffB); PG8_STAGE(PG8_SB(0, 1), cB + hstepB, voffB); PG8_STAGE(PG8_SA(0, 0), cA, voffA); PG8_STAGE(PG8_SA(0, 1), cA + hstepA, voffA);
        if (wr == 1) PG8_BAR;
        PG8_WAIT_V(2); PG8_BAR;
        PG8_STAGE(PG8_SB(1, 0), cB + kstep, voffB); PG8_STAGE(PG8_SA(1, 0), cA + kstep, voffA); PG8_STAGE(PG8_SB(1, 1), cB + hstepB + kstep, voffB);
        PG8_WAIT_V(6); PG8_BAR;
    } else {
        PG8_STAGE(PG8_SB(0, 0), cB, voffB); PG8_STAGE(PG8_SA(0, 0), cA, voffA); PG8_STAGE(PG8_SB(0, 1), cB + hstepB, voffB); PG8_STAGE(PG8_SA(0, 1), cA + hstepA, voffA);
        if (wr == 1) PG8_BAR;
        PG8_WAIT_V(4); PG8_BAR;
        PG8_STAGE(PG8_SB(1, 0), cB + kstep, voffB); PG8_STAGE(PG8_SA(1, 0), cA + kstep, voffA); PG8_STAGE(PG8_SB(1, 1), cB + hstepB + kstep, voffB);
        PG8_WAIT_V(6); PG8_BAR;
    }
    for (;;) {
        const bool has_next = S.next(ui + 1, nxt);
        const char* nA = has_next ? (const char*)g.A + (size_t)nxt.pm * tstepA : cA; const char* nB = has_next ? (const char*)g.Bt + (size_t)nxt.pn * tstepB : cB;
        for (int t = 0; t < nt; t += 2) {
            const bool last = (t == nt - 2);
            const char* a1 = cA + (size_t)(t + 1) * kstep;
            const char* a2 = last ? nA : cA + (size_t)(t + 2) * kstep; const char* b2 = last ? nB : cB + (size_t)(t + 2) * kstep;
            const char* a3 = a2 + kstep; const char* b3 = b2 + kstep;
            if (last && has_next) S.a_ready(nxt);
            if constexpr (SP2) {
            PG8_LDB(B0, 0, 0); PG8_LDB(B1, 0, 1); PG8_SCHED; PG8_LDA(At, 0, 0); PG8_STAGE(PG8_SA(1, 1), a1 + hstepA, voffA);
            PG8_WAIT_V(8); PG8_WAIT_L(0); PG8_BAR; PG8_MMA(0, 0, At, B0); PG8_MMA(0, 1, At, B1); PG8_BAR; PG8_SCHED;
            PG8_LDA(At, 0, 1); PG8_STAGE(PG8_SB(0, 0), b2, voffB); PG8_STAGE(PG8_SB(0, 1), b2 + hstepB, voffB); PG8_STAGE(PG8_SA(0, 0), a2, voffA);
            PG8_WAIT_V(8); PG8_WAIT_L(0); PG8_BAR; PG8_MMA(1, 0, At, B0); PG8_MMA(1, 1, At, B1); PG8_BAR; PG8_SCHED;
            PG8_LDB(B0, 1, 0); PG8_LDB(B1, 1, 1); PG8_SCHED; PG8_LDA(At, 1, 0); PG8_STAGE(PG8_SA(0, 1), a2 + hstepA, voffA);
            PG8_WAIT_V(8); PG8_WAIT_L(0); PG8_BAR; PG8_MMA(0, 0, At, B0); PG8_MMA(0, 1, At, B1); PG8_BAR; PG8_SCHED;
            PG8_LDA(At, 1, 1); PG8_STAGE(PG8_SB(1, 0), b3, voffB); PG8_STAGE(PG8_SB(1, 1), b3 + hstepB, voffB); PG8_STAGE(PG8_SA(1, 0), a3, voffA);
            PG8_WAIT_V(8); PG8_WAIT_L(0); PG8_BAR; PG8_MMA(1, 0, At, B0); PG8_MMA(1, 1, At, B1); PG8_BAR; PG8_SCHED;
            } else {
            PG8_LDB(B0, 0, 0); PG8_SCHED; PG8_LDA(At, 0, 0); PG8_STAGE(PG8_SA(1, 1), a1 + hstepA, voffA);
            PG8_WAIT_L(8); PG8_BAR; PG8_WAIT_L(0); PG8_MMA(0, 0, At, B0); PG8_BAR; PG8_SCHED;
            PG8_LDB(B1, 0, 1); PG8_STAGE(PG8_SB(0, 0), b2, voffB);
            PG8_BAR; PG8_WAIT_L(0); PG8_MMA(0, 1, At, B1); PG8_BAR;
            PG8_LDA(At, 0, 1); PG8_STAGE(PG8_SA(0, 0), a2, voffA);
            PG8_BAR; PG8_WAIT_L(0); PG8_MMA(1, 0, At, B0); PG8_BAR; PG8_SCHED;
            PG8_STAGE(PG8_SB(0, 1), b2 + hstepB, voffB);
            PG8_WAIT_V(6); PG8_BAR; PG8_MMA(1, 1, At, B1); PG8_BAR;
            PG8_LDB(B0, 1, 0); PG8_SCHED; PG8_LDA(At, 1, 0); PG8_STAGE(PG8_SA(0, 1), a2 + hstepA, voffA);
            PG8_WAIT_L(8); PG8_BAR; PG8_WAIT_L(0); PG8_MMA(0, 0, At, B0); PG8_BAR; PG8_SCHED;
            PG8_LDB(B1, 1, 1); PG8_STAGE(PG8_SB(1, 0), b3, voffB);
            PG8_BAR; PG8_WAIT_L(0); PG8_MMA(0, 1, At, B1); PG8_BAR;
            PG8_LDA(At, 1, 1); PG8_STAGE(PG8_SA(1, 0), a3, voffA);
            PG8_BAR; PG8_WAIT_L(0); PG8_MMA(1, 0, At, B0); PG8_BAR; PG8_SCHED;
            PG8_STAGE(PG8_SB(1, 1), b3 + hstepB, voffB);
            PG8_WAIT_V(6); PG8_BAR; PG8_MMA(1, 1, At, B1); PG8_BAR;
            }
        }
        if constexpr (ALIGN_EPI) { if (wr == 0) PG8_BAR; }
        if constexpr (!Epi::AFTER_DRAIN) { E(acc, cur, wr, wc, fr, fq); S.done(cur); }
        if (!has_next) break;
#pragma unroll
        for (int a = 0; a < 2; ++a)
#pragma unroll
            for (int b = 0; b < 2; ++b)
#pragma unroll
                for (int m = 0; m < 4; ++m)
#pragma unroll
                    for (int n = 0; n < 2; ++n) acc[a][b][m][n] = (f32x4){0.f, 0.f, 0.f, 0.f};
        cur = nxt; cA = nA; cB = nB; ++ui;
        if constexpr (ALIGN_EPI) { if (wr == 1) PG8_BAR; }
    }
    PG8_WAIT_V(0);
    if constexpr (!ALIGN_EPI) { if (wr == 0) PG8_BAR; }
    PG8_BAR;
    if constexpr (Epi::AFTER_DRAIN) { E.fused(acc, cur, wr, wc, fr, fq, lds, wid, lane); S.done(cur); }
#undef PG8_SA
#undef PG8_SB
#undef PG8_STAGE
#undef PG8_LDA
#undef PG8_LDB
#undef PG8_MMA
#undef PG8_WAIT_V
#undef PG8_WAIT_L
#undef PG8_BAR
#undef PG8_SCHED
}
}
using pg8::bf16_t; using pg8::bf16x8; using pg8::f32x4; using pg8::u32x4; using pg8::Unit;
typedef float f32x16 __attribute__((ext_vector_type(16)));
typedef float f32x2 __attribute__((ext_vector_type(2)));
typedef unsigned u32x2 __attribute__((ext_vector_type(2)));

constexpr int T = 32768, S = 16384, D = 1024, FF = 2816;
constexpr float EPS = 1e-6f, LOG2E = 1.4426950408889634f;
constexpr size_t MiB = 1u << 20;
constexpr size_t WS_XB = 0, WS_W = 64 * MiB, WS_R2 = 120 * MiB, WS_YA = 376 * MiB, WS_YC = 408 * MiB, WS_YB = 440 * MiB, WS_ST = 472 * MiB, WS_MISC = 488 * MiB, WS_END = 512 * MiB;
constexpr size_t W_1B = 0, W_1AC = 8 * MiB, W_1CVT = 11 * MiB, W_G = 12 * MiB, W_UQ = 20 * MiB, W_UK = 21 * MiB, W_UV = 21 * MiB + 512 * 1024, W_BR = 22 * MiB, W_OUT = 25 * MiB,
                 W_XQ = 27 * MiB, W_XK = 29 * MiB, W_XV = 31 * MiB, W_XO = 33 * MiB, W_13 = 35 * MiB, W_2 = 46 * MiB;
constexpr size_t R_BZ = 0, R_ACQ = 0, R_ACKV = 24 * MiB, R_CQ = 40 * MiB, R_CK = 72 * MiB, R_CVT = 80 * MiB, R_QA = 88 * MiB, R_KA = 136 * MiB, R_VAT = 184 * MiB,
                 R_PBR = 0, R_MERGED = 192 * MiB, R_QX = 0, R_OX = 64 * MiB, R_HID = 0;
constexpr size_t M_SS = 0, M_ROPE = 2 * MiB, M_BT = 4 * MiB, M_MEMN = 5 * MiB, M_KX = 7 * MiB, M_VXT = 8 * MiB, M_HD = 9 * MiB, M_BAR = 10 * MiB, M_SS64 = 14 * MiB;
constexpr int LDS_BYTES = 147456;

DEV float bf2f(bf16_t b) { return __uint_as_float((unsigned)b << 16); }
DEV unsigned pk2(float lo, float hi) { return pg8::cvt_pk_bf16(lo, hi); }
typedef __bf16 bf16x2_t __attribute__((ext_vector_type(2)));
DEV unsigned pk2b(float lo, float hi) { const f32x2 v = {lo, hi}; const bf16x2_t b = __builtin_convertvector(v, bf16x2_t); return __builtin_bit_cast(unsigned, b); }
DEV float wave_sum(float v) { _Pragma("unroll")
    for (int o = 1; o < 64; o <<= 1) v += __shfl_xor(v, o);
    return v;
}
DEV float sigmoidf_(float z) { return __builtin_amdgcn_rcpf(1.f + __expf(-z)); }
DEV float rstd_of(const unsigned long long* ss, int row, float invn) { return rsqrtf((float)ss[row] * (1.f / 16777216.f) * invn + EPS); }
DEV void st4(bf16_t* p, f32x4 v) { u32x2 w; w.x = pk2(v[0], v[1]); w.y = pk2(v[2], v[3]); *(u32x2*)p = w; }

#define XB_TMO      128
#define XB_XCNT(j)  (256  + 64 * (j))
#define XB_XSUB(j)  (1280 + 64 * (j))
#define XB_XGEN(j)  (2304 + 64 * (j))
#define XB_TOP      3328
#define XB_TOPGEN   3392
#define XCD_BAR_WORDS 3456
#define XB_SPIN_CAP (1u << 18)

__device__ __forceinline__ unsigned xb_ld(unsigned* p)              { return __hip_atomic_load(p, __ATOMIC_RELAXED, __HIP_MEMORY_SCOPE_AGENT); }
__device__ __forceinline__ unsigned xb_add(unsigned* p, unsigned v) { return __hip_atomic_fetch_add(p, v, __ATOMIC_RELAXED, __HIP_MEMORY_SCOPE_AGENT); }
__device__ __forceinline__ unsigned xb_xcc_id() { return (unsigned)__builtin_amdgcn_s_getreg((3 << 11) | 20) & 0xFu; }
#define XB_SPIN(cond, bar) do { unsigned _sp = 0; while (cond) { __builtin_amdgcn_s_sleep(1); \
    if ((++_sp & 255u) == 0u) { if (xb_ld(&(bar)[XB_TMO])) break; if (_sp > XB_SPIN_CAP) { atomicAdd(&(bar)[XB_TMO], 1u); break; } } } } while (0)

struct XcdBarrier {
    unsigned* bar; unsigned x;
    volatile PG8_LAS unsigned* st;
};

__device__ __forceinline__ XcdBarrier xcd_barrier_post(unsigned* bar, volatile PG8_LAS unsigned* st) {
    XcdBarrier b; b.bar = bar; b.x = xb_xcc_id(); b.st = st;
    if (threadIdx.x == 0) (void)xb_add(&bar[XB_XCNT(b.x)], 1u);
    return b;
}
__device__ __forceinline__ void xcd_barrier_complete(unsigned* bar, unsigned x, unsigned& nloc, unsigned& nx) {
    const unsigned G = gridDim.x * gridDim.y * gridDim.z;
    unsigned sum, cnt, mine, sp = 0u;
    for (;;) {
        sum = 0u; cnt = 0u; mine = 0u;
#pragma unroll
        for (unsigned j = 0; j < 16; ++j) { const unsigned c = xb_ld(&bar[XB_XCNT(j)]); sum += c; cnt += (c > 0u) ? 1u : 0u; mine = (j == x) ? c : mine; }
        if (sum == G) break;
        __builtin_amdgcn_s_sleep(1);
        if ((++sp & 255u) == 0u) { if (xb_ld(&bar[XB_TMO])) break; if (sp > XB_SPIN_CAP) { atomicAdd(&bar[XB_TMO], 1u); break; } }
    }
    nloc = mine > 0u ? mine : 1u; nx = cnt > 0u ? cnt : 1u;
}

__device__ __forceinline__ void xcd_barrier(const XcdBarrier& b) {
    asm volatile("s_waitcnt vmcnt(0)" ::: "memory");
    __syncthreads();
    if (threadIdx.x == 0) {
        unsigned* bar = b.bar;
        __builtin_amdgcn_s_waitcnt(0);
        unsigned nloc = b.st[0], nx = b.st[1];
        if (nloc == 0u) { xcd_barrier_complete(bar, b.x, nloc, nx); b.st[0] = nloc; b.st[1] = nx; }
        const unsigned old = xb_add(&bar[XB_XSUB(b.x)], 1u);
        const unsigned gen = old / nloc;
        if (old + 1u == (gen + 1u) * nloc) {
            __builtin_amdgcn_fence(__ATOMIC_RELEASE, "agent");
            asm volatile("s_waitcnt vmcnt(0)" ::: "memory");
            const unsigned og = xb_add(&bar[XB_TOP], 1u);
            const unsigned tg = og / nx;
            if (og + 1u == (tg + 1u) * nx) xb_add(&bar[XB_TOPGEN], 1u);
            else XB_SPIN(xb_ld(&bar[XB_TOPGEN]) == tg, bar);
            __builtin_amdgcn_fence(__ATOMIC_ACQUIRE, "agent");
            xb_add(&bar[XB_XGEN(b.x)], 1u);
            asm volatile("s_waitcnt vmcnt(0)" ::: "memory");
        } else {
            XB_SPIN(xb_ld(&bar[XB_XGEN(b.x)]) == gen, bar);
            __builtin_amdgcn_fence(__ATOMIC_ACQUIRE, "agent");
            asm volatile("s_waitcnt vmcnt(0)" ::: "memory");
        }
    }
    __syncthreads();
}

#define EPI_ROWS(...) _Pragma("unroll") for (int ai = 0; ai < 2; ++ai) _Pragma("unroll") for (int m = 0; m < 4; ++m) { const int row = u.pm * 256 + ai * 128 + wr * 64 + m * 16 + fr; __VA_ARGS__ }
#define EPI_COLS(...) _Pragma("unroll") for (int bj = 0; bj < 2; ++bj) _Pragma("unroll") for (int n = 0; n < 2; ++n) { const int col = u.pn * 256 + bj * 128 + wc * 32 + n * 16 + 4 * fq; const f32x4 v = acc[ai][bj][m][n]; __VA_ARGS__ }
typedef const f32x4 (&AccT)[2][2][4][2];

DEV unsigned char* launder(unsigned char* p) { unsigned lo = __builtin_amdgcn_readfirstlane((unsigned)(uintptr_t)p), hi = __builtin_amdgcn_readfirstlane((unsigned)((uintptr_t)p >> 32)); asm volatile("" : "+s"(lo), "+s"(hi)); return (unsigned char*)(((uintptr_t)hi << 32) | (uintptr_t)lo); }
typedef unsigned long long u64_t;
#define SSP(w_, i_) ((u64_t*)((w_) + WS_MISC + M_SS64) + (size_t)(i_) * T)
DEV u64_t ss_fix(float v) { return (u64_t)(v * 16777216.f + 0.5f); }
template <bool KMAP> struct EpiRow {
    static constexpr bool PERM = false, AFTER_DRAIN = false;
    unsigned char* ws; size_t off; int ldc; int ssi; float invn; float cs;
    DEV void operator()(AccT acc, const Unit& u, int wr, int wc, int fr, int fq) const {
        unsigned char* w = launder(ws); bf16_t* out = (bf16_t*)(w + off); const u64_t* ss = SSP(w, ssi);
        EPI_ROWS( const float rs = (ssi >= 0 ? rstd_of(ss, row, invn) : 1.f) * cs;
            EPI_COLS( const int oc = KMAP ? ((col >> 6) * 96 + (col & 63)) : col; st4(out + (size_t)row * ldc + oc, v * rs); ) )
    }
};
struct EpiRowP {
    static constexpr bool PERM = true, AFTER_DRAIN = false;
    unsigned char* ws; size_t off; int ldc; int ssi; float invn; float cs;
    DEV void operator()(AccT acc, const Unit& u, int wr, int wc, int fr, int fq) const {
        unsigned char* w = launder(ws); bf16_t* out = (bf16_t*)(w + off); const u64_t* ss = SSP(w, ssi);
        EPI_ROWS( const float rs = (ssi >= 0 ? rstd_of(ss, row, invn) : 1.f) * cs;
            _Pragma("unroll") for (int bj = 0; bj < 2; ++bj) { const f32x4 v0 = acc[ai][bj][m][0] * rs; const f32x4 v1 = acc[ai][bj][m][1] * rs;
                u32x4 o; o.x = pk2(v0[0], v0[1]); o.y = pk2(v0[2], v0[3]); o.z = pk2(v1[0], v1[1]); o.w = pk2(v1[2], v1[3]);
                *(u32x4*)(out + (size_t)row * ldc + u.pn * 256 + bj * 128 + wc * 32 + 8 * fq) = o; } )
    }
};
struct EpiCol {
    static constexpr bool PERM = false, AFTER_DRAIN = false;
    unsigned char* ws; size_t off; int ldc; int ssi; float invn; int rlim;
    DEV void operator()(AccT acc, const Unit& u, int wr, int wc, int fr, int fq) const {
        unsigned char* w = launder(ws); bf16_t* out = (bf16_t*)(w + off); const u64_t* ss = SSP(w, ssi);
        EPI_ROWS( if (row < rlim) {
            EPI_COLS( f32x4 s = {1.f, 1.f, 1.f, 1.f}; if (ssi >= 0) { s[0] = rstd_of(ss, col, invn); s[1] = rstd_of(ss, col + 1, invn); s[2] = rstd_of(ss, col + 2, invn); s[3] = rstd_of(ss, col + 3, invn); }
                st4(out + (size_t)row * ldc + col, v * s); ) } )
    }
};
struct EpiAC {
    static constexpr bool PERM = false, AFTER_DRAIN = false;
    unsigned char* ws; int l;
    DEV void operator()(AccT acc, const Unit& u, int wr, int wc, int fr, int fq) const {
        unsigned char* w = launder(ws); unsigned char* R2 = w + WS_R2;
        bf16_t* acq = (bf16_t*)(R2 + R_ACQ); bf16_t* ackv = (bf16_t*)(R2 + R_ACKV); bf16_t* cq = (bf16_t*)(R2 + R_CQ); bf16_t* ck = (bf16_t*)(R2 + R_CK); bf16_t* ka = (bf16_t*)(R2 + R_KA);
        const u64_t* ssm = SSP(w, l * 5); u64_t* ssq = SSP(w, l * 5 + 1); u64_t* sskv = SSP(w, l * 5 + 2);
        const float* rc = (const float*)(w + WS_MISC + M_ROPE); const float* rsn = rc + S * 16; const float cqs = 0.125f * LOG2E;
        const int pn = u.pn;
        EPI_ROWS( const float rs = rstd_of(ssm, row, 1.f / 1024.f);
            if (pn <= 2) { float sq = 0.f;
                EPI_COLS( const f32x4 wv = v * rs;
                    if (pn == 2) { st4(ackv + (size_t)row * 256 + (col - 512), wv); sq += (wv[0] * wv[0] + wv[1] * wv[1]) + (wv[2] * wv[2] + wv[3] * wv[3]); }
                    else if (col < 384) { st4(acq + (size_t)row * 384 + col, wv); sq += (wv[0] * wv[0] + wv[1] * wv[1]) + (wv[2] * wv[2] + wv[3] * wv[3]); }
                    else st4(ck + (size_t)row * 128 + (col - 384), wv); )
                sq += __shfl_xor(sq, 16); sq += __shfl_xor(sq, 32);
                if (fq == 0) atomicAdd((pn == 2 ? sskv : ssq) + row, ss_fix(sq));
            } else if (pn <= 4) { EPI_COLS( st4(cq + (size_t)row * 512 + (col - 768), v * (rs * cqs)); ) }
            else if (wc == 0) {
                const int pos = row & (S - 1); const f32x4 c4 = *(const f32x4*)(rc + pos * 16 + 4 * fq); const f32x4 s4 = *(const f32x4*)(rsn + pos * 16 + 4 * fq);
                const f32x4 x1 = acc[ai][0][m][0] * rs; const f32x4 x2 = acc[ai][0][m][1] * rs; const f32x4 o1 = x1 * c4 - x2 * s4; const f32x4 o2 = x1 * s4 + x2 * c4;
                _Pragma("unroll") for (int h = 0; h < 8; ++h) { st4(ka + (size_t)row * 768 + h * 96 + 64 + 4 * fq, o1); st4(ka + (size_t)row * 768 + h * 96 + 80 + 4 * fq, o2); } } )
    }
};
struct EpiQ {
    static constexpr bool PERM = false, AFTER_DRAIN = false;
    unsigned char* ws; int l;
    DEV void operator()(AccT acc, const Unit& u, int wr, int wc, int fr, int fq) const {
        unsigned char* w = launder(ws); bf16_t* qa = (bf16_t*)(w + WS_R2 + R_QA); const u64_t* ssq = SSP(w, l * 5 + 1);
        const float* rc = (const float*)(w + WS_MISC + M_ROPE); const float* rsn = rc + S * 16; const float qs = 0.10206207261596575f * LOG2E;
        EPI_ROWS( const float rs = rstd_of(ssq, row, 1.f / 384.f) * qs; const int pos = row & (S - 1);
            _Pragma("unroll") for (int bj = 0; bj < 2; ++bj) { const int col0 = u.pn * 256 + bj * 128 + wc * 32; const int g = col0 >> 5;
                f32x4 x1 = acc[ai][bj][m][0] * rs; f32x4 x2 = acc[ai][bj][m][1] * rs;
                if (g % 3 == 2) { const f32x4 c4 = *(const f32x4*)(rc + pos * 16 + 4 * fq); const f32x4 s4 = *(const f32x4*)(rsn + pos * 16 + 4 * fq);
                    const f32x4 o1 = x1 * c4 - x2 * s4; const f32x4 o2 = x1 * s4 + x2 * c4; x1 = o1; x2 = o2; }
                st4(qa + (size_t)row * 768 + col0 + 4 * fq, x1); st4(qa + (size_t)row * 768 + col0 + 16 + 4 * fq, x2); } )
    }
};
struct EpiMerge {
    static constexpr bool PERM = false, AFTER_DRAIN = false;
    unsigned char* ws; int l;
    DEV void operator()(AccT acc, const Unit& u, int wr, int wc, int fr, int fq) const {
        unsigned char* w = launder(ws); bf16_t* merged = (bf16_t*)(w + WS_R2 + R_MERGED); const bf16_t* pbr = (const bf16_t*)(w + WS_R2 + R_PBR); const u64_t* ssm = SSP(w, l * 5);
        const int mc = u.pn * 64 + wc * 16 + 4 * fq;
        EPI_ROWS( const float rs = rstd_of(ssm, row, 1.f / 1024.f); f32x4 o = {0.f, 0.f, 0.f, 0.f};
            _Pragma("unroll") for (int s = 0; s < 3; ++s) { const f32x4 g = acc[ai][s >> 1][m][s & 1] * rs; const u32x2 pw = *(const u32x2*)(pbr + (size_t)row * 3072 + s * 1024 + mc);
                o[0] += sigmoidf_(g[0]) * __uint_as_float(pw.x << 16); o[1] += sigmoidf_(g[1]) * __uint_as_float(pw.x & 0xffff0000u);
                o[2] += sigmoidf_(g[2]) * __uint_as_float(pw.y << 16); o[3] += sigmoidf_(g[3]) * __uint_as_float(pw.y & 0xffff0000u); }
            st4(merged + (size_t)row * 1024 + mc, o); )
    }
};
struct EpiRes {
    static constexpr bool PERM = false, AFTER_DRAIN = false;
    unsigned char* ws; const float* Xin; float* X; int ssi; int wxb;
    DEV void operator()(AccT acc, const Unit& u, int wr, int wc, int fr, int fq) const {
        unsigned char* w = launder(ws); bf16_t* xb = (bf16_t*)(w + WS_XB); u64_t* sso = SSP(w, ssi);
        EPI_ROWS( float sq = 0.f;
            EPI_COLS( const size_t xo = (size_t)row * 1024 + col; const f32x4 wv = *(const f32x4*)(Xin + xo) + v; *(f32x4*)(X + xo) = wv; if (wxb) st4(xb + (size_t)row * 1024 + col, wv);
                sq += (wv[0] * wv[0] + wv[1] * wv[1]) + (wv[2] * wv[2] + wv[3] * wv[3]); )
            sq += __shfl_xor(sq, 16); sq += __shfl_xor(sq, 32); if (fq == 0) atomicAdd(sso + row, ss_fix(sq)); )
    }
};
struct EpiFfn {
    static constexpr bool PERM = true, AFTER_DRAIN = false;
    unsigned char* ws; int ssi;
    DEV void operator()(AccT acc, const Unit& u, int wr, int wc, int fr, int fq) const {
        unsigned char* w = launder(ws); bf16_t* hid = (bf16_t*)(w + WS_R2 + R_HID); const u64_t* ss = SSP(w, ssi);
        EPI_ROWS( const float rs = rstd_of(ss, row, 1.f / 1024.f); f32x4 o[2];
            _Pragma("unroll") for (int n = 0; n < 2; ++n) { const f32x4 a = acc[ai][0][m][n] * rs; const f32x4 b = acc[ai][1][m][n] * rs;
                _Pragma("unroll") for (int i = 0; i < 4; ++i) o[n][i] = a[i] * sigmoidf_(a[i]) * b[i]; }
            u32x4 ow; ow.x = pk2(o[0][0], o[0][1]); ow.y = pk2(o[0][2], o[0][3]); ow.z = pk2(o[1][0], o[1][1]); ow.w = pk2(o[1][2], o[1][3]);
            *(u32x4*)(hid + (size_t)row * FF + u.pn * 128 + wc * 32 + 8 * fq) = ow; )
    }
};
template <class Epi> DEV void run_gemm(unsigned char* lds, const bf16_t* A, int lda, const bf16_t* Bt, int ldb, int M, int N, int K, const Epi& E) {
    pg8::Gemm g{A, Bt, M, N, K, lda, ldb}; pg8::StaticOrder So; So.init(M, N, (int)gridDim.x, (int)blockIdx.x);
    pg8::gemm_phase<Epi, pg8::StaticOrder, true, true>((PG8_LAS unsigned char*)lds, g, So, E);
}
template <int DQK, int DV, int NDP, int MODE, bool PF>
DEV void attn_unit(unsigned char* lds, const bf16_t* Q, int ldq, const bf16_t* K, int ldk, const bf16_t* VT, int ldvt, bf16_t* O, int ldo,
                   int kt0, int ntiles, int qpos0, const float* biasg, float sinkl2) {
    constexpr int KP = DQK + 8, VP = 72, DVW = DV / NDP, NKC = DQK / 8, KCH = 64 * NKC, VCH = DV * 8, NKL = (KCH + 511) / 512, NVL = (VCH + 511) / 512, ND0 = DQK / 16, NDB = DVW / 32;
    int tid_ = threadIdx.x; asm volatile("" : "+v"(tid_)); const int tid = tid_, lane = tid & 63, wid = __builtin_amdgcn_readfirstlane(tid >> 6), r32 = lane & 31, hi = lane >> 5;
    const int qg = wid / NDP, dp = wid % NDP;
    bf16_t* Kt = (bf16_t*)lds; bf16_t* Vt = Kt + 64 * KP; float* bt = (float*)(Vt + DV * VP);
    u32x4 kreg[NKL], vreg[NVL];
#define ATT_GLOAD(kt_) do { \
    _Pragma("unroll") for (int i = 0; i < NKL; ++i) { const int id = tid + 512 * i; if (KCH % 512 == 0 || id < KCH) { const int row = id / NKC, cc = id % NKC; kreg[i] = *(const u32x4*)(K + (size_t)((kt_) + row) * ldk + cc * 8); } } \
    _Pragma("unroll") for (int i = 0; i < NVL; ++i) { const int id = tid + 512 * i; if (VCH % 512 == 0 || id < VCH) { const int row = id >> 3, cc = id & 7; vreg[i] = *(const u32x4*)(VT + (size_t)row * ldvt + (kt_) + cc * 8); } } } while (0)
#define ATT_LSTORE() do { \
    _Pragma("unroll") for (int i = 0; i < NKL; ++i) { const int id = tid + 512 * i; if (KCH % 512 == 0 || id < KCH) { const int row = id / NKC, cc = id % NKC; *(u32x4*)(Kt + row * KP + cc * 8) = kreg[i]; } } \
    _Pragma("unroll") for (int i = 0; i < NVL; ++i) { const int id = tid + 512 * i; if (VCH % 512 == 0 || id < VCH) { const int row = id >> 3, cc = id & 7; *(u32x4*)(Vt + row * VP + cc * 8) = vreg[i]; } } } while (0)
    if (PF) ATT_GLOAD(kt0);
    bf16x8 qf[ND0];
#pragma unroll
    for (int d0 = 0; d0 < ND0; ++d0) qf[d0] = *(const bf16x8*)(Q + (size_t)(qg * 32 + r32) * ldq + d0 * 16 + hi * 8);
    float mrun = (MODE == 1) ? sinkl2 : -1e30f, lrun = (MODE == 1 && hi == 0) ? 1.f : 0.f;
    f32x16 o[NDB];
#pragma unroll
    for (int i = 0; i < NDB; ++i)
#pragma unroll
        for (int r = 0; r < 16; ++r) o[i][r] = 0.f;
    const int krow = 16 * (r32 >> 4) + 8 * ((r32 >> 2) & 1) + 4 * ((r32 >> 3) & 1) + (r32 & 3);
    const int qabs = qpos0 + qg * 32 + r32;
    for (int ti = 0; ti < ntiles; ++ti) {
        const int kt = kt0 + ti * 64;
        __syncthreads();
        if (!PF) ATT_GLOAD(kt);
        ATT_LSTORE();
        if (MODE == 1 && ti == 0) { for (int i = tid; i < 257; i += 512) bt[i] = biasg[i]; }
        __syncthreads();
        if (PF && ti + 1 < ntiles) ATT_GLOAD(kt + 64);
        bool skip = false;
        if (MODE == 1) { const int qlo = qpos0 + qg * 32; skip = (kt > qlo + 31 + 128) || (kt + 63 < qlo - 128); }
        if (!skip) {
            f32x16 p0, p1;
#pragma unroll
            for (int r = 0; r < 16; ++r) { p0[r] = 0.f; p1[r] = 0.f; }
#pragma unroll
            for (int d0 = 0; d0 < ND0; ++d0) {
                const bf16x8 k0 = *(const bf16x8*)(Kt + krow * KP + d0 * 16 + hi * 8), k1 = *(const bf16x8*)(Kt + (32 + krow) * KP + d0 * 16 + hi * 8);
                p0 = __builtin_amdgcn_mfma_f32_32x32x16_bf16(k0, qf[d0], p0, 0, 0, 0);
                p1 = __builtin_amdgcn_mfma_f32_32x32x16_bf16(k1, qf[d0], p1, 0, 0, 0);
            }
            if (MODE == 1) {
#pragma unroll
                for (int r = 0; r < 16; ++r) { const int rel0 = kt + 16 * (r >> 3) + 8 * hi + (r & 7) - qabs, rel1 = rel0 + 32;
                    const int i0 = min(max(rel0 + 128, 0), 256), i1 = min(max(rel1 + 128, 0), 256);
                    p0[r] = (rel0 >= -128 && rel0 <= 128) ? p0[r] + bt[i0] : -1e30f; p1[r] = (rel1 >= -128 && rel1 <= 128) ? p1[r] + bt[i1] : -1e30f; }
            }
            float mx = fmaxf(p0[0], p1[0]);
#pragma unroll
            for (int r = 1; r < 16; ++r) mx = fmaxf(mx, fmaxf(p0[r], p1[r]));
            mx = fmaxf(mx, __shfl_xor(mx, 32));
            const float mnew = fmaxf(mrun, mx), alpha = __builtin_amdgcn_exp2f(mrun - mnew); mrun = mnew;
            float rsum = 0.f;
#pragma unroll
            for (int r = 0; r < 16; ++r) { p0[r] = __builtin_amdgcn_exp2f(p0[r] - mnew); p1[r] = __builtin_amdgcn_exp2f(p1[r] - mnew); rsum += p0[r] + p1[r]; }
            lrun = lrun * alpha + rsum;
#pragma unroll
            for (int i = 0; i < NDB; ++i)
#pragma unroll
                for (int r = 0; r < 16; ++r) o[i][r] *= alpha;
            bf16x8 pb[4];
#pragma unroll
            for (int ks = 0; ks < 4; ++ks) { u32x4 w;
                if (ks < 2) { w.x = pk2(p0[8 * ks + 0], p0[8 * ks + 1]); w.y = pk2(p0[8 * ks + 2], p0[8 * ks + 3]); w.z = pk2(p0[8 * ks + 4], p0[8 * ks + 5]); w.w = pk2(p0[8 * ks + 6], p0[8 * ks + 7]); }
                else { const int k2 = ks - 2; w.x = pk2(p1[8 * k2 + 0], p1[8 * k2 + 1]); w.y = pk2(p1[8 * k2 + 2], p1[8 * k2 + 3]); w.z = pk2(p1[8 * k2 + 4], p1[8 * k2 + 5]); w.w = pk2(p1[8 * k2 + 6], p1[8 * k2 + 7]); }
                pb[ks] = __builtin_bit_cast(bf16x8, w); }
#pragma unroll
            for (int db = 0; db < NDB; ++db)
#pragma unroll
                for (int ks = 0; ks < 4; ++ks) {
                    const bf16x8 vf = *(const bf16x8*)(Vt + (dp * DVW + db * 32 + r32) * VP + ks * 16 + hi * 8);
                    o[db] = __builtin_amdgcn_mfma_f32_32x32x16_bf16(vf, pb[ks], o[db], 0, 0, 0);
                }
        }
    }
    const float ltot = lrun + __shfl_xor(lrun, 32), inv = 1.f / ltot;
    bf16_t* orow = O + (size_t)(qg * 32 + r32) * ldo + dp * DVW;
#pragma unroll
    for (int db = 0; db < NDB; ++db)
#pragma unroll
        for (int g4 = 0; g4 < 4; ++g4) { f32x4 w = {o[db][4 * g4] * inv, o[db][4 * g4 + 1] * inv, o[db][4 * g4 + 2] * inv, o[db][4 * g4 + 3] * inv}; st4(orow + db * 32 + 8 * g4 + 4 * hi, w); }
}
DEV float max3f(float a, float b, float c) { float r; asm("v_max3_f32 %0, %1, %2, %3" : "=v"(r) : "v"(a), "v"(b), "v"(c)); return r; }
DEV float hmax32(float x) { auto rr = __builtin_amdgcn_permlane32_swap(__float_as_uint(x), __float_as_uint(x), false, false); return fmaxf(__uint_as_float(rr[0]), __uint_as_float(rr[1])); }
DEV float hsum32(float x) { auto rr = __builtin_amdgcn_permlane32_swap(__float_as_uint(x), __float_as_uint(x), false, false); return __uint_as_float(rr[0]) + __uint_as_float(rr[1]); }
DEV void mla_unit(PG8_LAS unsigned char* lds, const bf16_t* Q, const bf16_t* K, const bf16_t* VT, bf16_t* O) {
    int tid_ = threadIdx.x; asm volatile("" : "+v"(tid_)); const int tid = tid_, lane = tid & 63, wid = __builtin_amdgcn_readfirstlane(tid >> 6), r32 = lane & 31, hi = lane >> 5;
    constexpr int BUFB = 22528, KBY = 13312, NT = S / 64;
    int kofs[2], vofs[2];
#pragma unroll
    for (int i = 0; i < 2; ++i) { const int idx = (wid + 8 * i) * 64 + lane; { const int row = idx / 13, cc = idx % 13; kofs[i] = row * 768 + (cc < 12 ? cc : 11) * 8; }
        { const int row = idx / 9, cc = idx % 9; vofs[i] = row * T + (cc < 8 ? cc : 7) * 8; } }
#define MLA_DMA(kt_, b_) do { \
    _Pragma("unroll") for (int i = 0; i < 2; ++i) if (wid + 8 * i < 13) __builtin_amdgcn_global_load_lds((const unsigned*)(K + (size_t)(kt_) * 768 + kofs[i]), (PG8_LAS unsigned*)(lds + (b_) * BUFB + (wid + 8 * i) * 1024), 16, 0, 0); \
    _Pragma("unroll") for (int i = 0; i < 2; ++i) if (wid + 8 * i < 9) __builtin_amdgcn_global_load_lds((const unsigned*)(VT + (kt_) + vofs[i]), (PG8_LAS unsigned*)(lds + (b_) * BUFB + KBY + (wid + 8 * i) * 1024), 16, 0, 0); } while (0)
    MLA_DMA(0, 0);
    bf16x8 qf[2][6];
#pragma unroll
    for (int sb = 0; sb < 2; ++sb)
#pragma unroll
        for (int d0 = 0; d0 < 6; ++d0) qf[sb][d0] = *(const bf16x8*)(Q + (size_t)(wid * 64 + sb * 32 + r32) * 768 + d0 * 16 + hi * 8);
    f32x16 negm[2], o[2][2]; float mhat[2] = {0.f, 0.f}, lrun[2] = {0.f, 0.f};
#pragma unroll
    for (int sb = 0; sb < 2; ++sb)
#pragma unroll
        for (int r = 0; r < 16; ++r) { negm[sb][r] = 0.f; o[sb][0][r] = 0.f; o[sb][1][r] = 0.f; }
    const int krow = 16 * (r32 >> 4) + 8 * ((r32 >> 2) & 1) + 4 * ((r32 >> 3) & 1) + (r32 & 3);
    const int kfo = (krow * 13 + hi) * 16, vfo = KBY + (r32 * 9 + hi) * 16;
    __syncthreads();
    for (int t = 0; t < NT; ++t) {
        const int cur = t & 1;
        if (t + 1 < NT) MLA_DMA((t + 1) * 64, cur ^ 1);
        PG8_LAS const unsigned char* Kb = lds + cur * BUFB;
        bf16x8 pb[2][4];
#pragma unroll
        for (int sb = 0; sb < 2; ++sb) {
            f32x16 p0, p1; int kfo_ = kfo; asm volatile("" : "+v"(kfo_));
#pragma unroll
            for (int d0 = 0; d0 < 6; ++d0) {
                const bf16x8 k0 = *(PG8_LAS const bf16x8*)(Kb + kfo_ + d0 * 32), k1 = *(PG8_LAS const bf16x8*)(Kb + kfo_ + 32 * 208 + d0 * 32);
                p0 = __builtin_amdgcn_mfma_f32_32x32x16_bf16(k0, qf[sb][d0], d0 == 0 ? negm[sb] : p0, 0, 0, 0);
                p1 = __builtin_amdgcn_mfma_f32_32x32x16_bf16(k1, qf[sb][d0], d0 == 0 ? negm[sb] : p1, 0, 0, 0);
            }
            asm volatile("s_nop 15\n\ts_nop 7" : "+v"(p0), "+v"(p1));
            float mx = max3f(p0[0], p1[0], p0[1]);
#pragma unroll
            for (int r = 1; r < 15; ++r) mx = max3f(mx, p1[r], p0[r + 1]);
            mx = hmax32(fmaxf(mx, p1[15]));
            if (t == 0 || __any(mx > 8.f)) {
                const float dl = (t == 0) ? mx : fmaxf(mx, 0.f); mhat[sb] += dl;
#pragma unroll
                for (int r = 0; r < 16; ++r) { p0[r] -= dl; p1[r] -= dl; negm[sb][r] = -mhat[sb]; }
                if (t != 0) { const float f = __builtin_amdgcn_exp2f(-dl); lrun[sb] *= f;
#pragma unroll
                    for (int r = 0; r < 16; ++r) { o[sb][0][r] *= f; o[sb][1][r] *= f; } }
            }
            float rsum = 0.f;
#pragma unroll
            for (int r = 0; r < 16; ++r) { p0[r] = __builtin_amdgcn_exp2f(p0[r]); p1[r] = __builtin_amdgcn_exp2f(p1[r]); rsum += p0[r] + p1[r]; }
            lrun[sb] += rsum;
#pragma unroll
            for (int ks = 0; ks < 4; ++ks) { u32x4 w;
                if (ks < 2) { w.x = pk2(p0[8 * ks + 0], p0[8 * ks + 1]); w.y = pk2(p0[8 * ks + 2], p0[8 * ks + 3]); w.z = pk2(p0[8 * ks + 4], p0[8 * ks + 5]); w.w = pk2(p0[8 * ks + 6], p0[8 * ks + 7]); }
                else { const int k2 = ks - 2; w.x = pk2(p1[8 * k2 + 0], p1[8 * k2 + 1]); w.y = pk2(p1[8 * k2 + 2], p1[8 * k2 + 3]); w.z = pk2(p1[8 * k2 + 4], p1[8 * k2 + 5]); w.w = pk2(p1[8 * k2 + 6], p1[8 * k2 + 7]); }
                pb[sb][ks] = __builtin_bit_cast(bf16x8, w); }
        }
#pragma unroll
        for (int db = 0; db < 2; ++db)
#pragma unroll
            for (int ks = 0; ks < 4; ++ks) {
                const bf16x8 vf = *(PG8_LAS const bf16x8*)(Kb + vfo + db * 32 * 144 + ks * 32);
                o[0][db] = __builtin_amdgcn_mfma_f32_32x32x16_bf16(vf, pb[0][ks], o[0][db], 0, 0, 0);
                o[1][db] = __builtin_amdgcn_mfma_f32_32x32x16_bf16(vf, pb[1][ks], o[1][db], 0, 0, 0);
            }
        __syncthreads();
    }
#pragma unroll
    for (int sb = 0; sb < 2; ++sb) {
        const float inv = 1.f / hsum32(lrun[sb]);
        bf16_t* orow = O + (size_t)(wid * 64 + sb * 32 + r32) * 512;
#pragma unroll
        for (int db = 0; db < 2; ++db)
#pragma unroll
            for (int g4 = 0; g4 < 4; ++g4) { f32x4 w = {o[sb][db][4 * g4] * inv, o[sb][db][4 * g4 + 1] * inv, o[sb][db][4 * g4 + 2] * inv, o[sb][db][4 * g4 + 3] * inv}; st4(orow + db * 32 + 8 * g4 + 4 * hi, w); }
    }
#undef MLA_DMA
}
typedef short s16x4 __attribute__((ext_vector_type(4)));
template <int PASS>
DEV void hgrn_task(unsigned char* lds, int task, int l, const bf16_t* BZ, float* E, float* Dd, float* OF, bf16_t* YB, const float* b_lb, const float* gout) {
    int tid_ = threadIdx.x; asm volatile("" : "+v"(tid_)); const int tid = tid_, lane = tid & 63, wid = __builtin_amdgcn_readfirstlane(tid >> 6), fr = lane & 15, fq = lane >> 4;
    const int b = task >> 7, h = (task >> 4) & 7, seg = task & 15, row0 = b * S + seg * 1024;
    constexpr int QP = 136;
    bf16_t* QD = (bf16_t*)lds; bf16_t* KI = QD + 64 * QP; bf16_t* KET = KI + 64 * QP; bf16_t* VT = KET + 4 * 128 * 16; float* DEC = (float*)(VT + 4 * 64 * 16); float* OUT = DEC + 512;
    const int pj = tid >> 7, pc = tid & 127;
    const int vn = (tid >> 1) & 63, vsh = tid & 1;
    const int nt = wid & 3;
    for (int dir = 0; dir < 2; ++dir) {
        const float lb = (l == 0) ? 0.f : sigmoidf_(b_lb[(dir * 2 + 1) * 1024 + h * 128 + pc] - b_lb[(dir * 2) * 1024 + h * 128 + pc]);
        f32x4 st[8];
#pragma unroll
        for (int j = 0; j < 8; ++j) st[j] = (f32x4){0.f, 0.f, 0.f, 0.f};
        if (PASS == 3 && wid < 4) {
            for (int q = 0; q < 15; ++q) { const int sp = dir ? 15 - q : q; if (dir ? (sp <= seg) : (sp >= seg)) break;
                const int tk = ((task & ~15) + sp) * 2 + dir; const float* dp = Dd + tk * 128; const float* ep = E + (size_t)tk * 8192 + 16 * nt + fr;
#pragma unroll
                for (int mt = 0; mt < 8; ++mt)
#pragma unroll
                    for (int i = 0; i < 4; ++i) { const int k = 16 * mt + 4 * fq + i; st[mt][i] = dp[k] * st[mt][i] + ep[k * 64]; } }
        }
        float dprod = 1.f;
        const bf16_t* zb = BZ + (dir ? 2048 : 1024) + h * 128 + pc; const bf16_t* qb = BZ + h * 128 + pc; const bf16_t* vb = BZ + 3072 + h * 64 + vn;
        unsigned short zr[16], qr[16], vv[8];
#define HROW(g_) (dir ? row0 + 1023 - (g_) : row0 + (g_))
#define HLOADS(g0_) do { _Pragma("unroll") for (int tp = 0; tp < 16; ++tp) { const size_t rb = (size_t)HROW((g0_) + pj * 16 + tp) * 4096; zr[tp] = zb[rb]; if (PASS == 3) qr[tp] = qb[rb]; } \
            _Pragma("unroll") for (int s8 = 0; s8 < 8; ++s8) vv[s8] = vb[(size_t)HROW((g0_) + pj * 16 + vsh * 8 + s8) * 4096]; } while (0)
        HLOADS(0);
        for (int stg = 0; stg < 16; ++stg) {
            const int g0 = stg * 64;
            {
                float P = 1.f; float ki[16], pv[16];
#pragma unroll
                for (int tp = 0; tp < 16; ++tp) { const float z = bf2f(zr[tp]);
                    const float sp = __builtin_amdgcn_rcpf(1.f + __expf(-z)), sn = __builtin_amdgcn_rcpf(1.f + __expf(z)); const float f = lb + (1.f - lb) * sp, key = (1.f - lb) * sn;
                    P *= f; const float kiv = key * __builtin_amdgcn_rcpf(fmaxf(P, 1e-36f)); ki[tp] = kiv;
                    pv[tp] = P; }
                if (PASS == 3) {
#pragma unroll
                    for (int tp = 0; tp < 16; ++tp) { const float qd_ = bf2f(qr[tp]) * pv[tp]; QD[(pj * 16 + tp) * QP + pc] = (bf16_t)(pk2b(qd_, 0.f) & 0xffffu); KI[(pj * 16 + tp) * QP + pc] = (bf16_t)(pk2b(ki[tp], 0.f) & 0xffffu); } }
                u32x4 w0, w1;
                w0.x = pk2(ki[0] * P, ki[1] * P); w0.y = pk2(ki[2] * P, ki[3] * P); w0.z = pk2(ki[4] * P, ki[5] * P); w0.w = pk2(ki[6] * P, ki[7] * P);
                w1.x = pk2(ki[8] * P, ki[9] * P); w1.y = pk2(ki[10] * P, ki[11] * P); w1.z = pk2(ki[12] * P, ki[13] * P); w1.w = pk2(ki[14] * P, ki[15] * P);
                *(u32x4*)(KET + (pj * 128 + pc) * 16) = w0; *(u32x4*)(KET + (pj * 128 + pc) * 16 + 8) = w1;
                DEC[pj * 128 + pc] = P; if (PASS == 1) dprod *= P;
                u32x4 vw; vw.x = vv[0] | ((unsigned)vv[1] << 16); vw.y = vv[2] | ((unsigned)vv[3] << 16); vw.z = vv[4] | ((unsigned)vv[5] << 16); vw.w = vv[6] | ((unsigned)vv[7] << 16);
                *(u32x4*)(VT + (pj * 64 + vn) * 16 + vsh * 8) = vw;
            }
            __syncthreads();
            if (stg + 1 < 16) HLOADS(g0 + 64);
            if (wid < 4) {
#pragma unroll 1
                for (int j = 0; j < 4; ++j) {
                    const bf16_t* QDj = QD + j * 16 * QP; const bf16_t* KIj = KI + j * 16 * QP; const bf16_t* KETj = KET + j * 128 * 16; const bf16_t* VTj = VT + j * 64 * 16; const float* DECj = DEC + j * 128;
                    const s16x4 vf = *(const s16x4*)(VTj + (16 * nt + fr) * 16 + 4 * fq);
                    if (PASS == 3) {
                        bf16x8 qd[4]; f32x4 sc = {0.f, 0.f, 0.f, 0.f};
#pragma unroll
                        for (int kk = 0; kk < 4; ++kk) { const s16x4 a0 = *(const s16x4*)(QDj + fr * QP + 32 * kk + 4 * fq), a1 = *(const s16x4*)(QDj + fr * QP + 32 * kk + 16 + 4 * fq);
                            qd[kk] = (bf16x8){a0[0], a0[1], a0[2], a0[3], a1[0], a1[1], a1[2], a1[3]};
                            const s16x4 b0 = *(const s16x4*)(KIj + fr * QP + 32 * kk + 4 * fq), b1 = *(const s16x4*)(KIj + fr * QP + 32 * kk + 16 + 4 * fq);
                            const bf16x8 kf = {b0[0], b0[1], b0[2], b0[3], b1[0], b1[1], b1[2], b1[3]};
                            sc = __builtin_amdgcn_mfma_f32_16x16x32_bf16(kf, qd[kk], sc, 0, 0, 0); asm volatile("" :: "v"(kf), "v"(qd[kk])); }
#pragma unroll
                        for (int i = 0; i < 4; ++i) if (4 * fq + i > fr) sc[i] = 0.f;
                        u32x2 sw; sw.x = pk2b(sc[0], sc[1]); sw.y = pk2b(sc[2], sc[3]);
                        const s16x4 swv = __builtin_bit_cast(s16x4, sw);
                        f32x4 z4 = {0.f, 0.f, 0.f, 0.f}; asm volatile("" : "+v"(z4));
                        const bf16x8 sw8 = {swv[0], swv[1], swv[2], swv[3], 0, 0, 0, 0}; const bf16x8 vf8 = {vf[0], vf[1], vf[2], vf[3], 0, 0, 0, 0};
                        f32x4 oacc = __builtin_amdgcn_mfma_f32_16x16x32_bf16(sw8, vf8, z4, 0, 0, 0); asm volatile("" :: "v"(swv), "v"(vf));
#pragma unroll
                        for (int kk = 0; kk < 4; ++kk) { u32x4 sb; sb.x = pk2b(st[2 * kk][0], st[2 * kk][1]); sb.y = pk2b(st[2 * kk][2], st[2 * kk][3]); sb.z = pk2b(st[2 * kk + 1][0], st[2 * kk + 1][1]); sb.w = pk2b(st[2 * kk + 1][2], st[2 * kk + 1][3]);
                            const bf16x8 sbv = __builtin_bit_cast(bf16x8, sb); oacc = __builtin_amdgcn_mfma_f32_16x16x32_bf16(qd[kk], sbv, oacc, 0, 0, 0); asm volatile("" :: "v"(qd[kk]), "v"(sbv)); }
#pragma unroll
                        for (int i = 0; i < 4; ++i) ((volatile float*)OUT)[(j * 16 + 4 * fq + i) * 64 + 16 * nt + fr] = oacc[i];
                    }
#pragma unroll
                    for (int mt = 0; mt < 8; ++mt) { const f32x4 d = *(const f32x4*)(DECj + 16 * mt + 4 * fq); const s16x4 kef = *(const s16x4*)(KETj + (16 * mt + fr) * 16 + 4 * fq);
                        const bf16x8 ke8 = {kef[0], kef[1], kef[2], kef[3], 0, 0, 0, 0}; const bf16x8 vu8 = {vf[0], vf[1], vf[2], vf[3], 0, 0, 0, 0};
                        st[mt] = __builtin_amdgcn_mfma_f32_16x16x32_bf16(ke8, vu8, st[mt] * d, 0, 0, 0); }
                }
            }
            __syncthreads();
            if (PASS == 3) {
                const int ps = dir ? 63 - (tid >> 3) : (tid >> 3), n8 = (tid & 7) * 8, row = HROW(g0 + ps);
                f32x4 o0 = *(const f32x4*)(OUT + ps * 64 + n8), o1 = *(const f32x4*)(OUT + ps * 64 + n8 + 4);
                float* ofp = OF + (size_t)row * 512 + h * 64 + n8;
                if (dir == 0) { *(f32x4*)ofp = o0; *(f32x4*)(ofp + 4) = o1; }
                else { o0 += *(const f32x4*)ofp; o1 += *(const f32x4*)(ofp + 4);
                    float sq = ((o0[0] * o0[0] + o0[1] * o0[1]) + (o0[2] * o0[2] + o0[3] * o0[3])) + ((o1[0] * o1[0] + o1[1] * o1[1]) + (o1[2] * o1[2] + o1[3] * o1[3]));
                    sq += __shfl_xor(sq, 1); sq += __shfl_xor(sq, 2); sq += __shfl_xor(sq, 4);
                    const float rn = rsqrtf(sq * (1.f / 64.f) + EPS); const u32x4 gw = *(const u32x4*)(BZ + (size_t)row * 4096 + 3584 + h * 64 + n8);
                    const f32x4 g0v = {__uint_as_float(gw.x << 16), __uint_as_float(gw.x & 0xffff0000u), __uint_as_float(gw.y << 16), __uint_as_float(gw.y & 0xffff0000u)};
                    const f32x4 g1v = {__uint_as_float(gw.z << 16), __uint_as_float(gw.z & 0xffff0000u), __uint_as_float(gw.w << 16), __uint_as_float(gw.w & 0xffff0000u)};
                    const f32x4 go0 = *(const f32x4*)(gout + l * 64 + n8), go1 = *(const f32x4*)(gout + l * 64 + n8 + 4); f32x4 y0, y1;
#pragma unroll
                    for (int j = 0; j < 4; ++j) { y0[j] = o0[j] * rn * go0[j] * (g0v[j] * sigmoidf_(g0v[j])); y1[j] = o1[j] * rn * go1[j] * (g1v[j] * sigmoidf_(g1v[j])); }
                    u32x4 yw; yw.x = pk2(y0[0], y0[1]); yw.y = pk2(y0[2], y0[3]); yw.z = pk2(y1[0], y1[1]); yw.w = pk2(y1[2], y1[3]);
                    *(u32x4*)(YB + (size_t)row * 512 + h * 64 + n8) = yw; }
            }
        }
#undef HLOADS
#undef HROW
        if (PASS == 1) { const int tk = task * 2 + dir;
            if (wid < 4) { float* ep = E + (size_t)tk * 8192 + 16 * nt + fr;
#pragma unroll
                for (int mt = 0; mt < 8; ++mt)
#pragma unroll
                    for (int i = 0; i < 4; ++i) ep[(16 * mt + 4 * fq + i) * 64] = st[mt][i]; }
            DEC[tid] = dprod; __syncthreads();
            if (pj == 0) Dd[tk * 128 + pc] = (DEC[pc] * DEC[128 + pc]) * (DEC[256 + pc] * DEC[384 + pc]); }
        __syncthreads();
    }
}

DEV void hgrn_pass3_valu(unsigned char* lds, int task, int l, const bf16_t* BZ, const float* E, const float* Dd, float* OF, bf16_t* YB, const float* b_lb, const float* gout) {
    int tid_ = threadIdx.x; asm volatile("" : "+v"(tid_)); const int tid = tid_, lane = tid & 63, kq = __builtin_amdgcn_readfirstlane(tid >> 6), np = lane & 31, k0 = 16 * kq + 8 * (lane >> 5);
    const int b = task >> 7, h = (task >> 4) & 7, seg = task & 15, row0 = b * S + seg * 1024;
    float* F = (float*)lds; float* QQ = F + 4096; float* V = QQ + 4096; float* PO = V + 2048;
    const int pt = tid >> 4, pk8 = (tid & 15) * 8, pn4 = (tid & 15) * 4;
    float lb[8]; f32x2 S2[2][4];
    u32x4 zw, qw; u32x2 vw;
#define H3_TB(it_) (row0 + ((((it_) >> 5) ? 31 - ((it_) & 31) : ((it_) & 31)) * 32))
#define H3_LOAD(it_, Z_, Q_, V_) do { const size_t rb_ = (size_t)(H3_TB(it_) + pt) * 4096; Z_ = *(const u32x4*)(BZ + rb_ + (((it_) >> 5) ? 2048 : 1024) + h * 128 + pk8); \
        Q_ = *(const u32x4*)(BZ + rb_ + h * 128 + pk8); V_ = *(const u32x2*)(BZ + rb_ + 3072 + h * 64 + pn4); } while (0)
    H3_LOAD(0, zw, qw, vw);
    for (int it = 0; it < 64; ++it) {
        const int dir = it >> 5, stg = it & 31, tb = H3_TB(it);
        if (stg == 0) {
#pragma unroll
            for (int j = 0; j < 8; ++j) { const int c = h * 128 + pk8 + j; lb[j] = (l == 0) ? 0.f : sigmoidf_(b_lb[(dir * 2 + 1) * 1024 + c] - b_lb[(dir * 2) * 1024 + c]); }
#pragma unroll
            for (int j = 0; j < 4; ++j) { S2[0][j] = (f32x2){0.f, 0.f}; S2[1][j] = (f32x2){0.f, 0.f}; }
            for (int q = 0; q < 15; ++q) { const int sp = dir ? 15 - q : q; if (dir ? (sp <= seg) : (sp >= seg)) break;
                const int tk = ((task & ~15) + sp) * 2 + dir; const float* dp = Dd + tk * 128 + k0; const float* ep = E + ((size_t)tk * 128 + k0) * 64 + np;
#pragma unroll
                for (int j = 0; j < 4; ++j)
#pragma unroll
                    for (int nn = 0; nn < 2; ++nn) { S2[nn][j].x = dp[2 * j] * S2[nn][j].x + ep[(2 * j) * 64 + 32 * nn]; S2[nn][j].y = dp[2 * j + 1] * S2[nn][j].y + ep[(2 * j + 1) * 64 + 32 * nn]; } }
        }
        {
            float fo[8];
#pragma unroll
            for (int j = 0; j < 8; ++j) { const unsigned w = zw[j >> 1]; const float z = (j & 1) ? __uint_as_float(w & 0xffff0000u) : __uint_as_float(w << 16);
                const float sp = __builtin_amdgcn_rcpf(1.f + __expf(-z)); fo[j] = lb[j] + (1.f - lb[j]) * sp; }
            *(f32x4*)(F + pt * 128 + pk8) = (f32x4){fo[0], fo[1], fo[2], fo[3]}; *(f32x4*)(F + pt * 128 + pk8 + 4) = (f32x4){fo[4], fo[5], fo[6], fo[7]};
            *(f32x4*)(QQ + pt * 128 + pk8) = (f32x4){__uint_as_float(qw.x << 16), __uint_as_float(qw.x & 0xffff0000u), __uint_as_float(qw.y << 16), __uint_as_float(qw.y & 0xffff0000u)};
            *(f32x4*)(QQ + pt * 128 + pk8 + 4) = (f32x4){__uint_as_float(qw.z << 16), __uint_as_float(qw.z & 0xffff0000u), __uint_as_float(qw.w << 16), __uint_as_float(qw.w & 0xffff0000u)};
            *(f32x4*)(V + pt * 64 + pn4) = (f32x4){__uint_as_float(vw.x << 16), __uint_as_float(vw.x & 0xffff0000u), __uint_as_float(vw.y << 16), __uint_as_float(vw.y & 0xffff0000u)};
        }
        __syncthreads();
        if (it + 1 < 64) H3_LOAD(it + 1, zw, qw, vw);
        const int crow = tb + pt; float* ofp = OF + (size_t)crow * 512 + h * 64 + pn4;
        f32x4 ofv = {0.f, 0.f, 0.f, 0.f}; u32x2 gw = {0u, 0u};
        if (dir == 1) { ofv = *(const f32x4*)ofp; gw = *(const u32x2*)(BZ + (size_t)crow * 4096 + 3584 + h * 64 + pn4); }
#define H3_LD(i_, FA_, FB_, QA_, QB_, V0_, V1_) do { const int t_ = dir ? 31 - (i_) : (i_); const f32x4* Fp_ = (const f32x4*)(F + t_ * 128 + k0); const f32x4* Qp_ = (const f32x4*)(QQ + t_ * 128 + k0); \
            FA_ = Fp_[0]; FB_ = Fp_[1]; QA_ = Qp_[0]; QB_ = Qp_[1]; V0_ = V[t_ * 64 + np]; V1_ = V[t_ * 64 + np + 32]; } while (0)
#define H3_HALF(j_, F4_, Q4_) do { const f32x2 fa = {F4_[0], F4_[1]}, fb = {F4_[2], F4_[3]}, ka = 1.f - fa, kb = 1.f - fb, qa = {Q4_[0], Q4_[1]}, qb = {Q4_[2], Q4_[3]}; \
            S2[0][2 * (j_)] = fa * S2[0][2 * (j_)] + ka * vv0; S2[0][2 * (j_) + 1] = fb * S2[0][2 * (j_) + 1] + kb * vv0; S2[1][2 * (j_)] = fa * S2[1][2 * (j_)] + ka * vv1; S2[1][2 * (j_) + 1] = fb * S2[1][2 * (j_) + 1] + kb * vv1; \
            po0 += qa * S2[0][2 * (j_)]; po0 += qb * S2[0][2 * (j_) + 1]; po1 += qa * S2[1][2 * (j_)]; po1 += qb * S2[1][2 * (j_) + 1]; } while (0)
#define H3_STEP(i_, FA_, FB_, QA_, QB_, V0_, V1_) do { const int t = dir ? 31 - (i_) : (i_); const f32x2 vv0 = {V0_, V0_}, vv1 = {V1_, V1_}; f32x2 po0 = {0.f, 0.f}, po1 = {0.f, 0.f}; \
            H3_HALF(0, FA_, QA_); H3_HALF(1, FB_, QB_); const float t0 = hsum32(po0.x + po0.y), t1 = hsum32(po1.x + po1.y); PO[(t * 8 + kq) * 64 + lane] = (lane < 32) ? t0 : t1; } while (0)
        {
            f32x4 fa0, fb0, qa0, qb0, fa1, fb1, qa1, qb1; float va0, vb0, va1, vb1;
            H3_LD(0, fa0, fb0, qa0, qb0, va0, vb0);
#pragma unroll 1
            for (int i = 0; i < 32; i += 2) {
                H3_LD(i + 1, fa1, fb1, qa1, qb1, va1, vb1);
                H3_STEP(i, fa0, fb0, qa0, qb0, va0, vb0);
                if (i + 2 < 32) H3_LD(i + 2, fa0, fb0, qa0, qb0, va0, vb0);
                H3_STEP(i + 1, fa1, fb1, qa1, qb1, va1, vb1);
            }
        }
#undef H3_LD
#undef H3_HALF
#undef H3_STEP
        __syncthreads();
        {
            f32x4 o = {0.f, 0.f, 0.f, 0.f};
#pragma unroll
            for (int q = 0; q < 8; ++q) o += *(const f32x4*)(PO + (pt * 8 + q) * 64 + pn4);
            if (dir == 0) *(f32x4*)ofp = o;
            else { o += ofv; float sq = (o[0] * o[0] + o[1] * o[1]) + (o[2] * o[2] + o[3] * o[3]);
                sq += __shfl_xor(sq, 1); sq += __shfl_xor(sq, 2); sq += __shfl_xor(sq, 4); sq += __shfl_xor(sq, 8);
                const float rn = rsqrtf(sq * (1.f / 64.f) + EPS);
                const f32x4 g = {__uint_as_float(gw.x << 16), __uint_as_float(gw.x & 0xffff0000u), __uint_as_float(gw.y << 16), __uint_as_float(gw.y & 0xffff0000u)};
                const f32x4 go = *(const f32x4*)(gout + l * 64 + pn4); f32x4 y;
#pragma unroll
                for (int j = 0; j < 4; ++j) y[j] = o[j] * rn * go[j] * (g[j] * sigmoidf_(g[j]));
                st4(YB + (size_t)crow * 512 + h * 64 + pn4, y); }
        }
    }
    __syncthreads();
#undef H3_TB
#undef H3_LOAD
}

DEV int prep_map(int kind, int r, int p0, int& sel) {
    sel = 0;
    switch (kind) {
    case 0: return p0 + r;
    case 1: if (r < 384) return r; if (r < 512) return 5280 + (r - 384); if (r < 768) return 384 + (r - 512); if (r < 1280) return 4768 + (r - 768); if (r < 1312) return 640 + (r - 1280); return -1;
    case 2: return r < 128 ? 5408 + r : -1;
    case 3: { const int pn = r >> 8, c = r & 255, s = 2 * (c >> 7) + ((c >> 4) & 1), mc = 16 * ((c >> 5) & 3) + (c & 15); return s < 3 ? 5536 + 1024 * s + 64 * pn + mc : -1; }
    case 4: return (r >> 6) * 128 + (r & 63);
    case 5: return (r >> 6) * 128 + 64 + (r & 63);
    default: { const int pn = r >> 8, c = r & 255; sel = c >> 7; return 128 * pn + (c & 127); }
    }
}
DEV void prep_item(const float* Wa, const float* Wb, const float* gain, int K, int Nsrc, bf16_t* dst, int rows, int kind, int p0, float* scr, int item, int lane) {
    const int nblk = rows / 32, kb = item / nblk, nb = item % nblk, k0 = 64 * kb, r0 = 32 * nb;
    int sel; const int col = prep_map(kind, r0 + (lane & 31), p0, sel); const float* W = sel ? Wb : Wa;
#pragma unroll 8
    for (int i = 0; i < 32; ++i) { const int kk = 2 * i + (lane >> 5); float v = (col >= 0) ? W[(size_t)(k0 + kk) * Nsrc + col] : 0.f; if (gain) v *= gain[k0 + kk]; scr[kk * 33 + (lane & 31)] = v; }
    asm volatile("s_waitcnt lgkmcnt(0)" ::: "memory");
    const int c = lane & 7;
#pragma unroll
    for (int j = 0; j < 4; ++j) { const int nn = (lane >> 3) + 8 * j; const float* s = scr + (8 * c) * 33 + nn;
        u32x4 o; o.x = pk2(s[0 * 33], s[1 * 33]); o.y = pk2(s[2 * 33], s[3 * 33]); o.z = pk2(s[4 * 33], s[5 * 33]); o.w = pk2(s[6 * 33], s[7 * 33]);
        *(u32x4*)(dst + (size_t)(r0 + nn) * K + k0 + 8 * c) = o; }
    asm volatile("s_waitcnt lgkmcnt(0)" ::: "memory");
}
struct Params { const float* in[26]; float* out; unsigned char* ws; int stop; int pad; };
struct Job { const float* Wa; const float* Wb; const float* gain; int K, Nsrc, rows, kind, p0; size_t off; };
DEV Job get_job(const Params& p, int j, int l) {
    Job J; J.Wb = nullptr; J.gain = nullptr; J.kind = 0; J.p0 = 0;
    const float* win = p.in[2] + (size_t)l * 1024 * 8608; const float* gmix = p.in[3] + l * 1024;
    switch (j) {
    case 0: J.Wa = win; J.gain = gmix; J.K = 1024; J.Nsrc = 8608; J.rows = 4096; J.p0 = 672; J.off = W_1B; break;
    case 1: J.Wa = win; J.gain = gmix; J.K = 1024; J.Nsrc = 8608; J.rows = 1536; J.kind = 1; J.off = W_1AC; break;
    case 2: J.Wa = win; J.gain = gmix; J.K = 1024; J.Nsrc = 8608; J.rows = 256; J.kind = 2; J.off = W_1CVT; break;
    case 3: J.Wa = win; J.gain = gmix; J.K = 1024; J.Nsrc = 8608; J.rows = 4096; J.kind = 3; J.off = W_G; break;
    case 4: J.Wa = p.in[6] + (size_t)l * 384 * 768; J.gain = p.in[4] + l * 384; J.K = 384; J.Nsrc = 768; J.rows = 768; J.off = W_UQ; break;
    case 5: J.Wa = p.in[7] + (size_t)l * 256 * 1024; J.gain = p.in[5] + l * 256; J.K = 256; J.Nsrc = 1024; J.rows = 512; J.kind = 4; J.off = W_UK; break;
    case 6: J.Wa = p.in[7] + (size_t)l * 256 * 1024; J.gain = p.in[5] + l * 256; J.K = 256; J.Nsrc = 1024; J.rows = 512; J.kind = 5; J.off = W_UV; break;
    case 7: J.Wa = p.in[12] + (size_t)l * 512 * 1024; J.K = 512; J.Nsrc = 1024; J.rows = 1024; J.off = W_BR; break;
    case 8: J.Wa = p.in[13] + (size_t)l * 512 * 1024; J.K = 512; J.Nsrc = 1024; J.rows = 1024; J.off = W_BR + MiB; break;
    case 9: J.Wa = p.in[14] + (size_t)l * 512 * 1024; J.K = 512; J.Nsrc = 1024; J.rows = 1024; J.off = W_BR + 2 * MiB; break;
    case 10: J.Wa = p.in[15] + (size_t)l * 1024 * 1024; J.K = 1024; J.Nsrc = 1024; J.rows = 1024; J.off = W_OUT; break;
    case 11: J.Wa = p.in[18] + (size_t)l * 1024 * 1024; J.gain = p.in[16] + l * 1024; J.K = 1024; J.Nsrc = 1024; J.rows = 1024; J.off = W_XQ; break;
    case 12: J.Wa = p.in[19] + (size_t)l * 1024 * 2048; J.K = 1024; J.Nsrc = 2048; J.rows = 1024; J.off = W_XK; break;
    case 13: J.Wa = p.in[19] + (size_t)l * 1024 * 2048; J.K = 1024; J.Nsrc = 2048; J.rows = 1024; J.p0 = 1024; J.off = W_XV; break;
    case 14: J.Wa = p.in[20] + (size_t)l * 1024 * 1024; J.K = 1024; J.Nsrc = 1024; J.rows = 1024; J.off = W_XO; break;
    case 15: J.Wa = p.in[22] + (size_t)l * 1024 * FF; J.Wb = p.in[23] + (size_t)l * 1024 * FF; J.gain = p.in[21] + l * 1024; J.K = 1024; J.Nsrc = FF; J.rows = 5632; J.kind = 6; J.off = W_13; break;
    default: J.Wa = p.in[24] + (size_t)l * FF * 1024; J.K = FF; J.Nsrc = 1024; J.rows = 1024; J.off = W_2; break;
    }
    return J;
}
DEV void prep_weights(const Params& p, int l, unsigned char* lds, int gw, int NGW, int wid, int lane) {
    float* scr = (float*)lds + wid * (64 * 33);
    int base = 0;
    for (int j = 0; j < 17; ++j) {
        const Job J = get_job(p, j, l); const int cnt = (J.K / 64) * (J.rows / 32);
        int first = gw - (base % NGW); if (first < 0) first += NGW;
        for (int r = first; r < cnt; r += NGW) prep_item(J.Wa, J.Wb, J.gain, J.K, J.Nsrc, (bf16_t*)(p.ws + WS_W + J.off), J.rows, J.kind, J.p0, scr, r, lane);
        base += cnt;
    }
}
#ifndef PHMASK
#define PHMASK 0xFFFFFFFFu
#endif
#define ON(k) (((PHMASK) >> (k)) & 1u)
#ifndef REPMASK
#define REPMASK 0u
#endif
#define REPS(k) ((((REPMASK) >> (k)) & 1u) ? 2 : 1)
DEV const Params* kparams() { const Params* q = (const Params*)__builtin_amdgcn_kernarg_segment_ptr(); asm volatile("" : "+s"(q)); return q; }
#define WPTR(off_) ((const bf16_t*)(w + WS_W + (off_)))
#define R2P(off_) ((bf16_t*)(w + WS_R2 + (off_)))
__global__ void __launch_bounds__(512, 2) mega(Params p_unused) {
    extern __shared__ __attribute__((aligned(16))) unsigned char lds[];
    cg::grid_group grid = cg::this_grid();
    {
        volatile PG8_LAS unsigned* st0 = (volatile PG8_LAS unsigned*)((PG8_LAS unsigned char*)lds + LDS_BYTES - 64);
        if (threadIdx.x == 0) { st0[0] = 0u; st0[1] = 0u; }
        __syncthreads();
        (void)xcd_barrier_post((unsigned*)(launder(kparams()->ws) + WS_MISC + M_BAR), st0);
    }
#define SEAM() do { XcdBarrier b_; b_.bar = (unsigned*)(launder(kparams()->ws) + WS_MISC + M_BAR); b_.x = xb_xcc_id(); b_.st = (volatile PG8_LAS unsigned*)((PG8_LAS unsigned char*)lds + LDS_BYTES - 64); xcd_barrier(b_); } while (0)
#define TIDS int tid_ = threadIdx.x; asm volatile("" : "+v"(tid_)); const int tid = tid_, lane = tid & 63, wid = __builtin_amdgcn_readfirstlane(tid >> 6); (void)tid; (void)lane; (void)wid;
    if (ON(0)) for (int rep_ = 0; rep_ < REPS(0); ++rep_) {
        TIDS const Params& p = *kparams(); unsigned char* w = launder(p.ws);
        const int G = gridDim.x, bx = blockIdx.x, gw = bx * 8 + wid, NGW = G * 8;
        bf16_t* XB = (bf16_t*)(w + WS_XB); u64_t* SS = SSP(w, 0);
        float* RC = (float*)(w + WS_MISC + M_ROPE); float* RS = RC + S * 16; float* BT = (float*)(w + WS_MISC + M_BT); bf16_t* MEMN = (bf16_t*)(w + WS_MISC + M_MEMN);
        const float* x = p.in[0];
        for (int row = gw; row < T; row += NGW) {
            const f32x4* xr = (const f32x4*)(x + (size_t)row * D) + lane; float ss = 0.f;
#pragma unroll
            for (int j = 0; j < 4; ++j) { const f32x4 v = xr[64 * j]; ss += (v[0] * v[0] + v[1] * v[1]) + (v[2] * v[2] + v[3] * v[3]);
                st4(XB + (size_t)row * D + (lane + 64 * j) * 4, v); }
            ss = wave_sum(ss); if (lane == 0) SS[row] = ss_fix(ss);
        }
        for (size_t i = (size_t)bx * 512 + tid; i < (size_t)10 * T; i += (size_t)G * 512) SS[T + i] = 0ull;
        for (int r = gw; r < 1024; r += NGW) {
            const int l = r >> 9, row = r & 511; const f32x4* xr = (const f32x4*)(p.in[1] + (size_t)row * D) + lane; f32x4 v[4]; float ss = 0.f;
#pragma unroll
            for (int j = 0; j < 4; ++j) { v[j] = xr[64 * j]; ss += (v[j][0] * v[j][0] + v[j][1] * v[j][1]) + (v[j][2] * v[j][2] + v[j][3] * v[j][3]); }
            const float rs = rsqrtf(wave_sum(ss) * (1.f / 1024.f) + EPS);
#pragma unroll
            for (int j = 0; j < 4; ++j) { const f32x4 g = *((const f32x4*)(p.in[17] + l * D) + lane + 64 * j); st4(MEMN + (size_t)r * D + (lane + 64 * j) * 4, v[j] * rs * g); }
        }
        for (int i = bx * 512 + tid; i < S * 16; i += G * 512) {
            const int pos = i >> 4, j = i & 15; const float inv = powf(10000.f, -(float)j / 16.f); const float ang = (float)pos * inv;
            const double a = (double)ang; const double k = rint(a * 0.15915494309189535); const float rr = (float)(a - k * 6.283185307179586);
            RC[i] = cosf(rr); RS[i] = sinf(rr);
        }
        for (int i = bx * 512 + tid; i < 8 * 260; i += G * 512) {
            const int h = i / 260, idx = i % 260; float val = 0.f;
            if (idx <= 256) { const int rel = idx - 128, n = rel < 0 ? -rel : rel; int bk = rel > 0 ? 16 : 0;
                if (n < 8) bk += n; else { int lg = 8 + (int)(logf((float)n / 8.f) / 2.772588722239781f * 8.f + 1e-4f); bk += lg < 15 ? lg : 15; }
                val = p.in[11][bk * 8 + h] * LOG2E; }
            BT[i] = val;
        }
        prep_weights(p, 0, lds, gw, NGW, wid, lane);
    }
    grid.sync();
#pragma unroll 1
    for (int l = 0; l < 2; ++l) {
        if (l == 1) { if (ON(0)) for (int rep_ = 0; rep_ < REPS(0); ++rep_) { TIDS const Params& p = *kparams(); prep_weights(p, 1, lds, blockIdx.x * 8 + wid, gridDim.x * 8, wid, lane); } SEAM(); }
        if (ON(1)) for (int rep_ = 0; rep_ < REPS(1); ++rep_) {
            unsigned char* w = launder(kparams()->ws); const bf16_t* memn = (const bf16_t*)(w + WS_MISC + M_MEMN) + (size_t)l * 512 * D;
            run_gemm(lds, (const bf16_t*)(w + WS_XB), D, WPTR(W_1B), D, T, 4096, D, EpiRowP{w, WS_R2 + R_BZ, 4096, l * 5, 1.f / 1024.f, 1.f});
            run_gemm(lds, memn, D, WPTR(W_XK), D, 512, 1024, D, EpiRowP{w, WS_MISC + M_KX, 1024, -1, 0.f, 1.f});
            run_gemm(lds, WPTR(W_XV), D, memn, D, 1024, 512, D, EpiCol{w, WS_MISC + M_VXT, 512, -1, 0.f, 1024});
        }
        SEAM();
        if (ON(2)) for (int rep_ = 0; rep_ < REPS(2); ++rep_) {
            const Params& p = *kparams(); unsigned char* w = launder(p.ws);
            for (int task = blockIdx.x; task < 256; task += gridDim.x) hgrn_task<1>(lds, task, l, R2P(R_BZ), (float*)(w + WS_ST), (float*)(w + WS_MISC + M_HD), (float*)(w + WS_YA), (bf16_t*)(w + WS_YB), p.in[8], p.in[9]);
        }
        SEAM();
        if (ON(3)) {
            const Params& p = *kparams(); unsigned char* w = launder(p.ws);
            for (int task = blockIdx.x; task < 256; task += gridDim.x) hgrn_task<3>(lds, task, l, R2P(R_BZ), (float*)(w + WS_ST), (float*)(w + WS_MISC + M_HD), (float*)(w + WS_YA), (bf16_t*)(w + WS_YB), p.in[8], p.in[9]);
        }
        SEAM();
        if (ON(5)) for (int rep_ = 0; rep_ < REPS(5); ++rep_) {
            unsigned char* w = launder(kparams()->ws);
            run_gemm(lds, (const bf16_t*)(w + WS_XB), D, WPTR(W_1AC), D, T, 1536, D, EpiAC{w, l});
            run_gemm(lds, WPTR(W_1CVT), D, (const bf16_t*)(w + WS_XB), D, 256, T, D, EpiCol{w, WS_R2 + R_CVT, T, l * 5, 1.f / 1024.f, 128});
        }
        SEAM();
        if (ON(6)) for (int rep_ = 0; rep_ < REPS(6); ++rep_) {
            unsigned char* w = launder(kparams()->ws);
            run_gemm(lds, R2P(R_ACQ), 384, WPTR(W_UQ), 384, T, 768, 384, EpiQ{w, l});
            run_gemm(lds, R2P(R_ACKV), 256, WPTR(W_UK), 256, T, 512, 256, EpiRow<true>{w, WS_R2 + R_KA, 768, l * 5 + 2, 1.f / 256.f, 1.f});
            run_gemm(lds, WPTR(W_UV), 256, R2P(R_ACKV), 256, 512, T, 256, EpiCol{w, WS_R2 + R_VAT, T, l * 5 + 2, 1.f / 256.f, 512});
        }
        SEAM();
        if (ON(7)) for (int rep_ = 0; rep_ < REPS(7); ++rep_) {
            const Params& p = *kparams(); unsigned char* w = launder(p.ws);
            const int G = gridDim.x, bx = blockIdx.x, vcu = (G % 8 == 0) ? (bx % 8) * (G / 8) + bx / 8 : bx;
            bf16_t* QA = R2P(R_QA); bf16_t* KA = R2P(R_KA); bf16_t* VAT = R2P(R_VAT); bf16_t* YA = (bf16_t*)(w + WS_YA);
            for (int i = 0; i < (512 + G - 1) / G; ++i) {
                const int u = (G == 256) ? (vcu >> 5) * 64 + i * 32 + (vcu & 31) : i * G + bx; if (u >= 512) break;
                const int bh = u >> 5, qb = u & 31, b = bh >> 3, h = bh & 7; const size_t row0 = (size_t)b * S + qb * 512;
                mla_unit((PG8_LAS unsigned char*)lds, QA + row0 * 768 + h * 96, KA + (size_t)b * S * 768 + h * 96, VAT + (size_t)(h * 64) * T + (size_t)b * S, YA + row0 * 512 + h * 64);
            }
            bf16_t* CQ = R2P(R_CQ); bf16_t* CK = R2P(R_CK); bf16_t* CVT = R2P(R_CVT); bf16_t* YC = (bf16_t*)(w + WS_YC); const float* BT = (const float*)(w + WS_MISC + M_BT);
            for (int u = bx; u < 1024; u += G) {
                const int bh = u >> 6, qb = u & 63, b = bh >> 3, h = bh & 7, kvh = h >> 2; const size_t row0 = (size_t)b * S + qb * 256;
                const int k0 = max(0, qb * 256 - 128), k1 = min(S, qb * 256 + 384);
                attn_unit<64, 64, 1, 1, true>(lds, CQ + row0 * 512 + h * 64, 512, CK + (size_t)b * S * 128 + kvh * 64, 128, CVT + (size_t)(kvh * 64) * T + (size_t)b * S, T, YC + row0 * 512 + h * 64, 512,
                                              k0, (k1 - k0) / 64, qb * 256, BT + h * 260, p.in[10][l * 8 + h] * LOG2E);
            }
        }
        SEAM();
        if (ON(8)) for (int rep_ = 0; rep_ < REPS(8); ++rep_) {
            unsigned char* w = launder(kparams()->ws);
            run_gemm(lds, (const bf16_t*)(w + WS_YA), 512, WPTR(W_BR), 512, T, 1024, 512, EpiRowP{w, WS_R2 + R_PBR, 3072, -1, 0.f, 1.f});
            run_gemm(lds, (const bf16_t*)(w + WS_YB), 512, WPTR(W_BR + MiB), 512, T, 1024, 512, EpiRowP{w, WS_R2 + R_PBR + 2048, 3072, -1, 0.f, 1.f});
            run_gemm(lds, (const bf16_t*)(w + WS_YC), 512, WPTR(W_BR + 2 * MiB), 512, T, 1024, 512, EpiRowP{w, WS_R2 + R_PBR + 4096, 3072, -1, 0.f, 1.f});
        }
        SEAM();
        if (ON(9)) for (int rep_ = 0; rep_ < REPS(9); ++rep_) { unsigned char* w = launder(kparams()->ws); run_gemm(lds, (const bf16_t*)(w + WS_XB), D, WPTR(W_G), D, T, 4096, D, EpiMerge{w, l}); }
        SEAM();
        if (ON(10)) for (int rep_ = 0; rep_ < REPS(10); ++rep_) { const Params& p = *kparams(); unsigned char* w = launder(p.ws); run_gemm(lds, R2P(R_MERGED), D, WPTR(W_OUT), D, T, 1024, D, EpiRes{w, l == 0 ? p.in[0] : (const float*)p.out, p.out, l * 5 + 3, 1}); }
        SEAM();
        if (ON(11)) for (int rep_ = 0; rep_ < REPS(11); ++rep_) { unsigned char* w = launder(kparams()->ws); run_gemm(lds, (const bf16_t*)(w + WS_XB), D, WPTR(W_XQ), D, T, 1024, D, EpiRowP{w, WS_R2 + R_QX, 1024, l * 5 + 3, 1.f / 1024.f, 0.0625f * LOG2E}); }
        SEAM();
        if (ON(12)) for (int rep_ = 0; rep_ < REPS(12); ++rep_) {
            unsigned char* w = launder(kparams()->ws); bf16_t* QX = R2P(R_QX); bf16_t* OX = R2P(R_OX); const bf16_t* KX = (const bf16_t*)(w + WS_MISC + M_KX); const bf16_t* VXT = (const bf16_t*)(w + WS_MISC + M_VXT);
            for (int u = blockIdx.x; u < 1024; u += gridDim.x) {
                const int qb = u >> 2, h = u & 3; const size_t row0 = (size_t)qb * 128; const int b = qb >> 7;
                attn_unit<256, 256, 2, 0, false>(lds, QX + row0 * 1024 + h * 256, 1024, KX + (size_t)b * 256 * 1024 + h * 256, 1024, VXT + (size_t)(h * 256) * 512 + b * 256, 512, OX + row0 * 1024 + h * 256, 1024, 0, 4, 0, nullptr, 0.f);
            }
        }
        SEAM();
        if (ON(13)) for (int rep_ = 0; rep_ < REPS(13); ++rep_) { const Params& p = *kparams(); unsigned char* w = launder(p.ws); run_gemm(lds, R2P(R_OX), D, WPTR(W_XO), D, T, 1024, D, EpiRes{w, p.out, p.out, l * 5 + 4, 1}); }
        SEAM();
        if (ON(14)) for (int rep_ = 0; rep_ < REPS(14); ++rep_) { unsigned char* w = launder(kparams()->ws); run_gemm(lds, (const bf16_t*)(w + WS_XB), D, WPTR(W_13), D, T, 5632, D, EpiFfn{w, l * 5 + 4}); }
        SEAM();
        if (ON(15)) for (int rep_ = 0; rep_ < REPS(15); ++rep_) { const Params& p = *kparams(); unsigned char* w = launder(p.ws); run_gemm(lds, R2P(R_HID), FF, WPTR(W_2), FF, T, 1024, FF, EpiRes{w, p.out, p.out, (l + 1) * 5, l == 0 ? 1 : 0}); }
        SEAM();
    }
    {
        TIDS const Params& p = *kparams(); unsigned char* w = launder(p.ws); float* X = p.out; const u64_t* ssf = SSP(w, 10);
        for (int row = blockIdx.x * 8 + wid; row < T; row += gridDim.x * 8) {
            const float rs = rstd_of(ssf, row, 1.f / 1024.f); f32x4* xr = (f32x4*)(X + (size_t)row * D) + lane;
#pragma unroll
            for (int j = 0; j < 4; ++j) { const f32x4 g = *((const f32x4*)p.in[25] + lane + 64 * j); xr[64 * j] = xr[64 * j] * rs * g; }
        }
    }
}

extern "C" void kernel_launch(void* const* d_in, const int* in_sizes, int n_in, void* d_out, int out_size, void* d_ws, size_t ws_size, hipStream_t stream) {
    static int grid_blocks = 0;
    if (grid_blocks == 0) {
        if (n_in != 26 || out_size != T * D || ws_size < WS_END) { fprintf(stderr, "kernel_launch: unexpected shapes n_in %d out %d ws %zu\n", n_in, out_size, ws_size); grid_blocks = -1; return; }
        int dev = 0, cus = 0, per_cu = 0;
        (void)hipGetDevice(&dev); (void)hipDeviceGetAttribute(&cus, hipDeviceAttributeMultiprocessorCount, dev);
        (void)hipFuncSetAttribute((const void*)mega, hipFuncAttributeMaxDynamicSharedMemorySize, LDS_BYTES);
        if (hipOccupancyMaxActiveBlocksPerMultiprocessor(&per_cu, (const void*)mega, 512, LDS_BYTES) != hipSuccess || per_cu < 1) per_cu = 1;
        (void)hipGetLastError();
        grid_blocks = cus * 1;
        fprintf(stderr, "kernel_launch: grid %d (cus %d, per_cu %d), ws %zu\n", grid_blocks, cus, per_cu, ws_size);
    }
    if (grid_blocks < 0) return;
    if (hipMemsetAsync((unsigned char*)d_ws + WS_MISC + M_BAR, 0, 16384, stream) != hipSuccess) { fprintf(stderr, "kernel_launch: memset of the barrier words failed\n"); return; }
    Params p{};
    for (int i = 0; i < 26; ++i) p.in[i] = (const float*)d_in[i];
    p.out = (float*)d_out; p.ws = (unsigned char*)d_ws; p.stop = 0; p.pad = 0;
    void* args[] = {&p};
    hipError_t e = hipLaunchCooperativeKernel((void*)mega, dim3(grid_blocks), dim3(512), args, LDS_BYTES, stream);
    if (e != hipSuccess) fprintf(stderr, "cooperative launch failed: %s (grid %d)\n", hipGetErrorString(e), grid_blocks);
}
```
